# Optimizing an MI355X kernel written in HIP

```python
import math, functools
import jax, jax.numpy as jnp
from jax import lax
import numpy as np

D_MODEL = 1024
BATCH = 8
SEQ = 2048
DEPTH = 2

GRID_W = 64
CTX_LEN = 256
HEAD_DIM = 64
ROPE_THETA = 10000.0
ROPE_FREQS = HEAD_DIM // 4
Q_BLOCK = 128
A_HEADS = 8
A_KV_HEADS = 2
B_HEADS = 4
B_V_DIM = 2 * HEAD_DIM
C_HEADS = 8
C_KV_HEADS = 2
C_WINDOW = 128
D_HEADS = 8
NA_ROWS = 8
NA_COLS = 16
EVEN_SPLITS = (A_HEADS * HEAD_DIM, A_KV_HEADS * HEAD_DIM, A_KV_HEADS * HEAD_DIM,
               2 * B_HEADS * HEAD_DIM, 2 * B_HEADS * HEAD_DIM, B_HEADS * B_V_DIM)
ODD_SPLITS = (C_HEADS * HEAD_DIM, C_KV_HEADS * HEAD_DIM, C_KV_HEADS * HEAD_DIM,
              D_HEADS * HEAD_DIM, D_HEADS * HEAD_DIM, D_HEADS * HEAD_DIM)
IN_WIDTH = sum(EVEN_SPLITS)
MIX_WIDTH = A_HEADS * HEAD_DIM + B_HEADS * B_V_DIM
D_FF = 4 * D_MODEL
N_EVEN = (DEPTH + 1) // 2
N_ODD = DEPTH // 2
EPS = 1e-6
NEG = -1e30

kernel_name = "hybrid_dit_prefix_block"


def split_cols(p, sizes):
    return jnp.split(p, np.cumsum(sizes)[:-1].tolist(), axis=-1)


def rms_norm(x, g):
    xf = x.astype(jnp.float32)
    y = xf * lax.rsqrt(jnp.mean(jnp.square(xf), axis=-1, keepdims=True) + EPS)
    return (y * g.astype(jnp.float32)).astype(x.dtype)


def modulate(h, shift, scale):
    return h * (1 + scale) + shift


def lambda_init(layer):
    return 0.8 - 0.6 * math.exp(-0.3 * layer)


def axial_rope_tables(T, dtype):
    t = jnp.arange(T, dtype=jnp.int32)
    pos = jnp.stack([t // GRID_W, t % GRID_W], axis=-1).astype(jnp.float32)
    inv = ROPE_THETA ** (-jnp.arange(ROPE_FREQS, dtype=jnp.float32) / ROPE_FREQS)
    ang = pos[..., None] * inv
    return jnp.cos(ang).astype(dtype), jnp.sin(ang).astype(dtype)


def apply_axial_rope(x, cos, sin):
    xs = x.reshape(x.shape[:-1] + (2, 2, ROPE_FREQS))
    x1, x2 = xs[..., 0, :], xs[..., 1, :]
    c, s = cos[:, None], sin[:, None]
    return jnp.stack([x1 * c - x2 * s, x2 * c + x1 * s], axis=-2).reshape(x.shape)


def map_query_blocks(fn, *qs):
    B, T = qs[0].shape[:2]
    nb = T // Q_BLOCK
    blocks = tuple(jnp.moveaxis(a.reshape((B, nb, Q_BLOCK) + a.shape[2:]), 1, 0) for a in qs)
    out = lax.map(lambda args: fn(*args), blocks)
    return jnp.moveaxis(out, 0, 1).reshape((B, T) + out.shape[3:])


def gqa_attend(q, k, v):
    s = jnp.einsum('bqkgd,bskd->bkgqs', q, k).astype(jnp.float32)
    p = jax.nn.softmax(s, axis=-1).astype(v.dtype)
    return jnp.einsum('bkgqs,bskd->bqkgd', p, v)


def diff_attend(q, k, v, lam):
    s = jnp.einsum('bqhjd,bshjd->bhjqs', q, k).astype(jnp.float32)
    p = jax.nn.softmax(s, axis=-1)
    a = (p[:, :, 0] - lam * p[:, :, 1]).astype(v.dtype)
    return jnp.einsum('bhqs,bshe->bqhe', a, v)


def sink_attend(q, k, v, sink):
    s = jnp.einsum('bqkgd,bskd->bkgqs', q, k).astype(jnp.float32)
    sk = jnp.broadcast_to(sink.astype(jnp.float32)[None, :, :, None, None], s.shape[:-1] + (1,))
    p = jax.nn.softmax(jnp.concatenate([sk, s], axis=-1), axis=-1)[..., 1:].astype(v.dtype)
    return jnp.einsum('bkgqs,bskd->bqkgd', p, v)


def windowed_attend(q, k, v, k_ctx, v_ctx, sink):
    B, T = q.shape[:2]
    L = k_ctx.shape[1]
    nb = T // C_WINDOW

    def band(a):
        ap = jnp.pad(a, ((0, 0), (C_WINDOW, C_WINDOW), (0, 0), (0, 0)))
        ap = ap.reshape((B, nb + 2, C_WINDOW) + a.shape[2:])
        return jnp.concatenate([ap[:, :-2], ap[:, 1:-1], ap[:, 2:]], axis=2)

    kb, vb = band(k), band(v)
    qb = q.reshape((B, nb, C_WINDOW) + q.shape[2:])
    i = jnp.arange(C_WINDOW)[:, None]
    j = jnp.arange(3 * C_WINDOW)[None, :]
    kpos = jnp.arange(nb)[:, None, None] * C_WINDOW - C_WINDOW + j
    valid = (jnp.abs(j - C_WINDOW - i) <= C_WINDOW)[None] & (kpos >= 0) & (kpos < T)
    s_loc = jnp.einsum('bnqkgd,bnskd->bnkgqs', qb, kb).astype(jnp.float32)
    s_loc = jnp.where(valid[None, :, None, None], s_loc, NEG)
    s_ctx = jnp.einsum('bnqkgd,bskd->bnkgqs', qb, k_ctx).astype(jnp.float32)
    sk = jnp.broadcast_to(sink.astype(jnp.float32)[None, None, :, :, None, None], s_ctx.shape[:-1] + (1,))
    p = jax.nn.softmax(jnp.concatenate([sk, s_ctx, s_loc], axis=-1), axis=-1)
    p_ctx = p[..., 1:1 + L].astype(v.dtype)
    p_loc = p[..., 1 + L:].astype(v.dtype)
    o = (jnp.einsum('bnkgqs,bskd->bnqkgd', p_ctx, v_ctx)
         + jnp.einsum('bnkgqs,bnskd->bnqkgd', p_loc, vb))
    return o.reshape(q.shape)


def neighborhood_attend(q, k, v, k_ctx, v_ctx, rpb):
    B, T, H, Dh = q.shape
    rows = T // GRID_W
    kh = min(NA_ROWS, rows)
    kw = NA_COLS
    L = k_ctx.shape[1]
    r = jnp.arange(rows)
    rs = jnp.clip(r - kh // 2, 0, rows - kh)
    row_idx = rs[:, None] + jnp.arange(kh)[None, :]

    def gather_rows(a):
        return a.reshape(B, rows, GRID_W, H, Dh)[:, row_idx].reshape(B, rows, kh * GRID_W, H, Dh)

    kg, vg = gather_rows(k), gather_rows(v)
    qg = q.reshape(B, rows, GRID_W, H, Dh)
    cq = jnp.arange(GRID_W)
    cs = jnp.clip(cq - kw // 2, 0, GRID_W - kw)
    ck = jnp.tile(jnp.arange(GRID_W), kh)
    col_valid = (ck[None] >= cs[:, None]) & (ck[None] < cs[:, None] + kw)
    dr = jnp.repeat(row_idx - r[:, None], GRID_W, axis=1)
    dc = jnp.clip(ck[None] - cq[:, None], -(kw - 1), kw - 1)
    bias = rpb[:, dr[:, None, :] + NA_ROWS - 1, dc[None] + NA_COLS - 1]
    bias = jnp.moveaxis(bias, 0, 1).astype(jnp.float32)
    s_loc = jnp.einsum('brqhd,brshd->brhqs', qg, kg).astype(jnp.float32) + bias
    s_loc = jnp.where(col_valid, s_loc, NEG)
    s_ctx = jnp.einsum('brqhd,bshd->brhqs', qg, k_ctx).astype(jnp.float32)
    p = jax.nn.softmax(jnp.concatenate([s_ctx, s_loc], axis=-1), axis=-1)
    p_ctx = p[..., :L].astype(v.dtype)
    p_loc = p[..., L:].astype(v.dtype)
    o = (jnp.einsum('brhqs,bshd->brqhd', p_ctx, v_ctx)
         + jnp.einsum('brhqs,brshd->brqhd', p_loc, vg))
    return o.reshape(B, T, H * Dh)


def even_mixer(h_x, h_c, w_in, w_out, qk_g, lam_p, subln_g, lam0, cos, sin, with_ctx):
    scale = HEAD_DIM ** -0.5
    g_a = A_HEADS // A_KV_HEADS

    def project(h, rope):
        n, s = h.shape[:2]
        qa, ka, va, qb, kb, vb = split_cols(h @ w_in, EVEN_SPLITS)
        qa = rms_norm(qa.reshape(n, s, A_HEADS, HEAD_DIM), qk_g[0])
        ka = rms_norm(ka.reshape(n, s, A_KV_HEADS, HEAD_DIM), qk_g[1])
        qb = qb.reshape(n, s, 2 * B_HEADS, HEAD_DIM)
        kb = kb.reshape(n, s, 2 * B_HEADS, HEAD_DIM)
        if rope:
            qa, ka = apply_axial_rope(qa, cos, sin), apply_axial_rope(ka, cos, sin)
            qb, kb = apply_axial_rope(qb, cos, sin), apply_axial_rope(kb, cos, sin)
        return ((qa * scale).reshape(n, s, A_KV_HEADS, g_a, HEAD_DIM), ka,
                va.reshape(n, s, A_KV_HEADS, HEAD_DIM),
                (qb * scale).reshape(n, s, B_HEADS, 2, HEAD_DIM),
                kb.reshape(n, s, B_HEADS, 2, HEAD_DIM),
                vb.reshape(n, s, B_HEADS, B_V_DIM))

    lam = (jnp.exp(jnp.sum(lam_p[0] * lam_p[1]).astype(jnp.float32))
           - jnp.exp(jnp.sum(lam_p[2] * lam_p[3]).astype(jnp.float32)) + lam0)
    qa_x, ka_x, va_x, qb_x, kb_x, vb_x = project(h_x, True)
    qa_c, ka_c, va_c, qb_c, kb_c, vb_c = project(h_c, False)
    ka_all = jnp.concatenate([ka_c, ka_x], axis=1)
    va_all = jnp.concatenate([va_c, va_x], axis=1)
    kb_all = jnp.concatenate([kb_c, kb_x], axis=1)
    vb_all = jnp.concatenate([vb_c, vb_x], axis=1)
    B, T = h_x.shape[:2]
    o_a = map_query_blocks(lambda q: gqa_attend(q, ka_all, va_all), qa_x).reshape(B, T, -1)
    o_b = map_query_blocks(lambda q: diff_attend(q, kb_all, vb_all, lam), qb_x)
    o_b = (rms_norm(o_b, subln_g) * (1 - lam0)).reshape(B, T, -1)
    out_x = jnp.concatenate([o_a, o_b], axis=-1) @ w_out
    out_c = None
    if with_ctx:
        n, L = h_c.shape[:2]
        oa_c = gqa_attend(qa_c, ka_c, va_c).reshape(n, L, -1)
        ob_c = (rms_norm(diff_attend(qb_c, kb_c, vb_c, lam), subln_g) * (1 - lam0)).reshape(n, L, -1)
        out_c = jnp.concatenate([oa_c, ob_c], axis=-1) @ w_out
    return out_x, out_c


def odd_mixer(h_x, h_c, w_in, w_out, sink, rpb, cos, sin, with_ctx):
    scale = HEAD_DIM ** -0.5
    g_c = C_HEADS // C_KV_HEADS
    sink = sink.reshape(C_KV_HEADS, g_c)

    def project(h, rope):
        n, s = h.shape[:2]
        qc, kc, vc, qd, kd, vd = split_cols(h @ w_in, ODD_SPLITS)
        qc = qc.reshape(n, s, C_HEADS, HEAD_DIM)
        kc = kc.reshape(n, s, C_KV_HEADS, HEAD_DIM)
        if rope:
            qc, kc = apply_axial_rope(qc, cos, sin), apply_axial_rope(kc, cos, sin)
        return ((qc * scale).reshape(n, s, C_KV_HEADS, g_c, HEAD_DIM), kc,
                vc.reshape(n, s, C_KV_HEADS, HEAD_DIM),
                qd.reshape(n, s, D_HEADS, HEAD_DIM) * scale,
                kd.reshape(n, s, D_HEADS, HEAD_DIM),
                vd.reshape(n, s, D_HEADS, HEAD_DIM))

    qc_x, kc_x, vc_x, qd_x, kd_x, vd_x = project(h_x, True)
    qc_c, kc_c, vc_c, qd_c, kd_c, vd_c = project(h_c, False)
    B, T = h_x.shape[:2]
    o_c = windowed_attend(qc_x, kc_x, vc_x, kc_c, vc_c, sink).reshape(B, T, -1)
    o_d = neighborhood_attend(qd_x, kd_x, vd_x, kd_c, vd_c, rpb)
    out_x = jnp.concatenate([o_c, o_d], axis=-1) @ w_out
    out_c = None
    if with_ctx:
        n, L = h_c.shape[:2]
        oc_c = sink_attend(qc_c, kc_c, vc_c, sink).reshape(n, L, -1)
        od_c = gqa_attend(qd_c[:, :, :, None], kd_c, vd_c).reshape(n, L, -1)
        out_c = jnp.concatenate([oc_c, od_c], axis=-1) @ w_out
    return out_x, out_c


def squared_relu_mlp(h, w1, w2):
    return jnp.square(jax.nn.relu(h @ w1)) @ w2


def setup_inputs(seed: int = 0) -> dict:
    key = jax.random.key(seed)
    ks = jax.random.split(key, 16)
    f32 = jnp.float32

    def nrm(k, shape, s):
        return jax.random.normal(k, shape, f32) * s

    return {
        "x": nrm(ks[0], (BATCH, SEQ, D_MODEL), 1.0),
        "c": nrm(ks[1], (BATCH, D_MODEL), 1.0),
        "ctx": nrm(ks[2], (BATCH, CTX_LEN, D_MODEL), 1.0),
        "c_ctx": nrm(ks[3], (D_MODEL,), 1.0),
        "w_mod": nrm(ks[4], (DEPTH, D_MODEL, 6 * D_MODEL), D_MODEL ** -0.5),
        "b_mod": nrm(ks[5], (DEPTH, 6 * D_MODEL), 0.02),
        "norm_g": 1.0 + nrm(ks[6], (DEPTH, 4, D_MODEL), 0.02),
        "w_in": nrm(ks[7], (DEPTH, D_MODEL, IN_WIDTH), D_MODEL ** -0.5),
        "w_out": nrm(ks[8], (DEPTH, MIX_WIDTH, D_MODEL), MIX_WIDTH ** -0.5),
        "w_mlp_in": nrm(ks[9], (DEPTH, D_MODEL, D_FF), D_MODEL ** -0.5),
        "w_mlp_out": nrm(ks[10], (DEPTH, D_FF, D_MODEL), D_FF ** -0.5),
        "qk_norm_a": 1.0 + nrm(ks[11], (N_EVEN, 2, HEAD_DIM), 0.02),
        "diff_lambda": nrm(ks[12], (N_EVEN, 4, HEAD_DIM), 0.1),
        "diff_subln": 1.0 + nrm(ks[13], (N_EVEN, B_V_DIM), 0.02),
        "sink_c": nrm(ks[14], (N_ODD, C_HEADS), 0.5),
        "rpb_d": nrm(ks[15], (N_ODD, D_HEADS, 2 * NA_ROWS - 1, 2 * NA_COLS - 1), 0.1),
    }


def reference(x, c, ctx, c_ctx, w_mod, b_mod, norm_g, w_in, w_out, w_mlp_in, w_mlp_out,
              qk_norm_a, diff_lambda, diff_subln, sink_c, rpb_d):
    T = x.shape[1]
    cos, sin = axial_rope_tables(T, x.dtype)
    s_x = jax.nn.silu(c)
    s_c = jax.nn.silu(c_ctx)
    for l in range(DEPTH):
        last = l == DEPTH - 1
        mod_x = (s_x @ w_mod[l] + b_mod[l])[:, None, :]
        mod_c = s_c @ w_mod[l] + b_mod[l]
        sh1_x, sc1_x, g1_x, sh2_x, sc2_x, g2_x = jnp.split(mod_x, 6, axis=-1)
        sh1_c, sc1_c, g1_c, sh2_c, sc2_c, g2_c = jnp.split(mod_c, 6, axis=-1)
        h_x = modulate(rms_norm(x, norm_g[l, 0]), sh1_x, sc1_x)
        h_c = modulate(rms_norm(ctx, norm_g[l, 0]), sh1_c, sc1_c)
        if l % 2 == 0:
            i = l // 2
            m_x, m_c = even_mixer(h_x, h_c, w_in[l], w_out[l], qk_norm_a[i], diff_lambda[i],
                                  diff_subln[i], lambda_init(l), cos, sin, not last)
        else:
            i = l // 2
            m_x, m_c = odd_mixer(h_x, h_c, w_in[l], w_out[l], sink_c[i], rpb_d[i],
                                 cos, sin, not last)
        x = x + g1_x * rms_norm(m_x, norm_g[l, 1])
        f_x = squared_relu_mlp(modulate(rms_norm(x, norm_g[l, 2]), sh2_x, sc2_x), w_mlp_in[l], w_mlp_out[l])
        x = x + g2_x * rms_norm(f_x, norm_g[l, 3])
        if not last:
            ctx = ctx + g1_c * rms_norm(m_c, norm_g[l, 1])
            f_c = squared_relu_mlp(modulate(rms_norm(ctx, norm_g[l, 2]), sh2_c, sc2_c), w_mlp_in[l], w_mlp_out[l])
            ctx = ctx + g2_c * rms_norm(f_c, norm_g[l, 3])
    return x
```

```cpp
#include <hip/hip_runtime.h>
#include <hip/hip_cooperative_groups.h>
#include <cstdint>
#include <cstdio>
namespace cg = cooperative_groups;

#ifndef MULTI
#define MULTI 0
#endif

#define DI __device__ __forceinline__
typedef unsigned short bf16_t;
typedef short bf16x8 __attribute__((ext_vector_type(8)));
typedef short s16x4 __attribute__((ext_vector_type(4)));
typedef float f32x2 __attribute__((ext_vector_type(2)));
typedef float f32x4 __attribute__((ext_vector_type(4)));
typedef float f32x16 __attribute__((ext_vector_type(16)));
typedef unsigned u32x2 __attribute__((ext_vector_type(2)));
typedef unsigned u32x4 __attribute__((ext_vector_type(4)));
typedef __bf16 bf16x2_t __attribute__((ext_vector_type(2)));

constexpr int NB = 8, T = 2048, LC = 256, P = 2304, R = NB * P, DM = 1024, INW = 2304, FF = 4096;
constexpr float EPS = 1e-6f;
constexpr float LOG2E = 1.4426950408889634f;

constexpr size_t OFF_BAR = 0;
constexpr size_t OFF_MOD = 16384;
constexpr size_t OFF_ROPE = OFF_MOD + 2 * 9 * 6144 * 4;
constexpr size_t OFF_WIN = 524288;
constexpr size_t OFF_WOUT = OFF_WIN + (size_t)2 * INW * DM * 2;
constexpr size_t OFF_W1 = OFF_WOUT + (size_t)2 * DM * DM * 2;
constexpr size_t OFF_W2 = OFF_W1 + (size_t)2 * FF * DM * 2;
constexpr size_t OFF_X = OFF_W2 + (size_t)2 * FF * DM * 2;
constexpr size_t OFF_A = OFF_X + (size_t)R * DM * 4;
constexpr size_t OFF_B = OFF_A + (size_t)R * DM * 2;
constexpr size_t OFF_Q = OFF_B;
constexpr size_t OFF_K = OFF_Q + (size_t)R * DM * 2;
constexpr size_t OFF_VT = OFF_K + (size_t)R * 640 * 2;
constexpr size_t WS_END = OFF_VT + (size_t)R * 640 * 2;

struct Params {
  const float *x, *c, *ctx, *c_ctx, *w_mod, *b_mod, *norm_g, *w_in, *w_out, *w_mlp_in, *w_mlp_out, *qk_norm_a, *diff_lambda, *diff_subln, *sink_c, *rpb_d;
  float* out;
  unsigned char* ws;
};

struct Ctx { int tid, bid, nb; };
DI unsigned pk2(float lo, float hi) { f32x2 v = {lo, hi}; return __builtin_bit_cast(unsigned, __builtin_convertvector(v, bf16x2_t)); }
DI float bflo(unsigned u) { return __uint_as_float(u << 16); }
DI float bfhi(unsigned u) { return __uint_as_float(u & 0xffff0000u); }
DI int clampi(int v, int lo, int hi) { return v < lo ? lo : (v > hi ? hi : v); }
DI int crow(int i, int hh) { return (i & 3) + 8 * (i >> 2) + 4 * hh; }

#define XB_TMO      128
#define XB_XCNT(j)  (256  + 64 * (j))
#define XB_XSUB(j)  (1280 + 64 * (j))
#define XB_XGEN(j)  (2304 + 64 * (j))
#define XB_TOP      3328
#define XB_TOPGEN   3392
#define XCD_BAR_WORDS 3456
#define XB_SPIN_CAP (1u << 20)
DI unsigned xb_ld(unsigned* p) { return __hip_atomic_load(p, __ATOMIC_RELAXED, __HIP_MEMORY_SCOPE_AGENT); }
DI unsigned xb_add(unsigned* p, unsigned v) { return __hip_atomic_fetch_add(p, v, __ATOMIC_RELAXED, __HIP_MEMORY_SCOPE_AGENT); }
DI unsigned xb_xcc_id() { return (unsigned)__builtin_amdgcn_s_getreg((3 << 11) | 20) & 0xFu; }
#define XB_SPIN(cond, bar) do { unsigned _sp = 0; while (cond) { __builtin_amdgcn_s_sleep(1); \
    if ((++_sp & 255u) == 0u) { if (xb_ld(&(bar)[XB_TMO])) break; if (_sp > XB_SPIN_CAP) { atomicAdd(&(bar)[XB_TMO], 1u); break; } } } } while (0)
struct XcdBarrier { unsigned* bar; unsigned x; unsigned nloc, nx; };
DI void xcd_barrier_complete(unsigned* bar, unsigned x, unsigned& nloc, unsigned& nx) {
  const unsigned G = gridDim.x * gridDim.y * gridDim.z;
  unsigned sum, cnt, mine, sp = 0u;
  for (;;) {
    sum = 0u; cnt = 0u; mine = 0u;
#pragma unroll
    for (unsigned j = 0; j < 16; ++j) { const unsigned c = xb_ld(&bar[XB_XCNT(j)]); sum += c; cnt += (c > 0u) ? 1u : 0u; mine = (j == x) ? c : mine; }
    if (sum == G) break;
    __builtin_amdgcn_s_sleep(1);
    if ((++sp & 255u) == 0u) { if (xb_ld(&bar[XB_TMO])) break; if (sp > XB_SPIN_CAP) { atomicAdd(&bar[XB_TMO], 1u); break; } }
  }
  nloc = mine > 0u ? mine : 1u; nx = cnt > 0u ? cnt : 1u;
}
DI void xcd_barrier(XcdBarrier& b) {
  asm volatile("s_waitcnt vmcnt(0)" ::: "memory");
  __syncthreads();
  if (threadIdx.x == 0) {
    unsigned* bar = b.bar;
    __builtin_amdgcn_s_waitcnt(0);
    if (b.nloc == 0u) xcd_barrier_complete(bar, b.x, b.nloc, b.nx);
    const unsigned nloc = b.nloc, nx = b.nx;
    const unsigned old = xb_add(&bar[XB_XSUB(b.x)], 1u);
    const unsigned gen = old / nloc;
    if (old + 1u == (gen + 1u) * nloc) {
      __builtin_amdgcn_fence(__ATOMIC_RELEASE, "agent");
      asm volatile("s_waitcnt vmcnt(0)" ::: "memory");
      const unsigned og = xb_add(&bar[XB_TOP], 1u);
      const unsigned tg = og / nx;
      if (og + 1u == (tg + 1u) * nx) xb_add(&bar[XB_TOPGEN], 1u);
      else XB_SPIN(xb_ld(&bar[XB_TOPGEN]) == tg, bar);
      __builtin_amdgcn_fence(__ATOMIC_ACQUIRE, "agent");
      xb_add(&bar[XB_XGEN(b.x)], 1u);
      asm volatile("s_waitcnt vmcnt(0)" ::: "memory");
    } else {
      XB_SPIN(xb_ld(&bar[XB_XGEN(b.x)]) == gen, bar);
      __builtin_amdgcn_fence(__ATOMIC_ACQUIRE, "agent");
      asm volatile("s_waitcnt vmcnt(0)" ::: "memory");
    }
  }
  __syncthreads();
}

DI void p0_transpose(const Ctx& cx, const float* W, bf16_t* Wt, int K, int N, int tk, int tn, unsigned char* lds) {
  float* s = (float*)lds;
  const int t = cx.tid;
  __syncthreads();
#pragma unroll
  for (int i = 0; i < 16; ++i) { const int k = i * 4 + (t >> 6), n = t & 63; s[k * 65 + n] = W[(size_t)(tk * 64 + k) * N + tn * 64 + n]; }
  __syncthreads();
#pragma unroll
  for (int i = 0; i < 8; ++i) { const int n = i * 8 + (t >> 5), kk = (t & 31) * 2;
    *(unsigned*)(Wt + (size_t)(tn * 64 + n) * K + tk * 64 + kk) = pk2(s[kk * 65 + n], s[(kk + 1) * 65 + n]); }
}
DI void p0_mod(const Ctx& cx, const Params& p, int item, unsigned char* lds) {
  float* sS = (float*)lds;
  float* red = (float*)(lds + 9 * 1024 * 4);
  const int t = cx.tid, lane = t & 63, w = t >> 6;
  const int l = item / 96, cc = item % 96;
  __syncthreads();
  for (int e = t; e < 9 * 1024; e += 256) { const int i = e >> 10, k = e & 1023; const float v = (i < 8) ? p.c[i * 1024 + k] : p.c_ctx[k]; sS[e] = v / (1.f + __expf(-v)); }
  __syncthreads();
  float acc[9];
#pragma unroll
  for (int i = 0; i < 9; ++i) acc[i] = 0.f;
  const float* wp = p.w_mod + (size_t)l * 1024 * 6144 + cc * 64 + lane;
  for (int k = w * 256; k < w * 256 + 256; ++k) { const float wv = wp[(size_t)k * 6144];
#pragma unroll
    for (int i = 0; i < 9; ++i) acc[i] += sS[i * 1024 + k] * wv; }
#pragma unroll
  for (int i = 0; i < 9; ++i) red[(w * 9 + i) * 64 + lane] = acc[i];
  __syncthreads();
  float* mod = (float*)(p.ws + OFF_MOD);
  for (int e = t; e < 576; e += 256) { const int i = e >> 6, n = e & 63;
    const float v = red[(0 * 9 + i) * 64 + n] + red[(1 * 9 + i) * 64 + n] + red[(2 * 9 + i) * 64 + n] + red[(3 * 9 + i) * 64 + n] + p.b_mod[l * 6144 + cc * 64 + n];
    mod[(size_t)(l * 9 + i) * 6144 + cc * 64 + n] = v; }
}
DI void phase_prep(const Ctx& cx, const Params& p, unsigned char* lds) {
  constexpr int N_MOD = 192, N_ROPE = 1;
  constexpr int TW_IN = 16 * 36, TW_OUT = 16 * 16, TW_1 = 16 * 64, TW_2 = 64 * 16, TW_L = TW_IN + TW_OUT + TW_1 + TW_2;
  const int total = N_MOD + N_ROPE + 2 * TW_L;
  for (int it = cx.bid; it < total; it += cx.nb) {
    if (it < N_MOD) { p0_mod(cx, p, it, lds); }
    else if (it < N_MOD + N_ROPE) {
      float* rt = (float*)(p.ws + OFF_ROPE);
      for (int e = cx.tid; e < 1024; e += 256) { const int pos = e >> 4, f = e & 15; const float inv = powf(10000.f, -(float)f / 16.f); const float ang = (float)pos * inv;
        rt[e] = cosf(ang); rt[1024 + e] = sinf(ang); }
    } else {
      int i = it - N_MOD - N_ROPE; const int l = i / TW_L; i -= l * TW_L;
      if (i < TW_IN) { p0_transpose(cx, p.w_in + (size_t)l * DM * INW, (bf16_t*)(p.ws + OFF_WIN) + (size_t)l * INW * DM, DM, INW, i / 36, i % 36, lds); }
      else if (i < TW_IN + TW_OUT) { i -= TW_IN; p0_transpose(cx, p.w_out + (size_t)l * DM * DM, (bf16_t*)(p.ws + OFF_WOUT) + (size_t)l * DM * DM, DM, DM, i / 16, i % 16, lds); }
      else if (i < TW_IN + TW_OUT + TW_1) { i -= TW_IN + TW_OUT; p0_transpose(cx, p.w_mlp_in + (size_t)l * DM * FF, (bf16_t*)(p.ws + OFF_W1) + (size_t)l * FF * DM, DM, FF, i / 64, i % 64, lds); }
      else { i -= TW_IN + TW_OUT + TW_1; p0_transpose(cx, p.w_mlp_out + (size_t)l * FF * DM, (bf16_t*)(p.ws + OFF_W2) + (size_t)l * DM * FF, FF, DM, i / 16, i % 16, lds); }
    }
  }
}

DI float wave_sum(float v) {
#pragma unroll
  for (int o = 32; o >= 1; o >>= 1) v += __shfl_xor(v, o);
  return v;
}
DI void phase_rowpass(const Ctx& cx, const Params& p, int mode, int layer) {
  const int lane = cx.tid & 63, w = cx.tid >> 6;
  const bool latent_only = (layer == 1 && mode != 0);
  const int nrows = latent_only ? NB * T : R;
  float* X = (float*)(p.ws + OFF_X);
  bf16_t* HA = (bf16_t*)(p.ws + OFF_A);
  const bf16_t* MF = (const bf16_t*)(p.ws + OFF_B);
  const float* mod = (const float*)(p.ws + OFF_MOD);
  for (int it = cx.bid * 4 + w; it < nrows; it += cx.nb * 4) {
    const int row = latent_only ? ((it >> 11) * P + LC + (it & 2047)) : it;
    const int b = row / P, pp = row - b * P, mi = (pp < LC) ? 8 : b;
    const float* modp = mod + (size_t)(layer * 9 + mi) * 6144;
    const float* resid;
    if (mode == 0 || (mode == 1 && layer == 0)) resid = (pp < LC) ? p.ctx + ((size_t)b * LC + pp) * DM : p.x + ((size_t)b * T + pp - LC) * DM;
    else resid = X + (size_t)row * DM;
    f32x4 xv[4];
#pragma unroll
    for (int i = 0; i < 4; ++i) xv[i] = *(const f32x4*)(resid + lane * 4 + 256 * i);
    if (mode != 0) {
      const bf16_t* src = (mode == 1 ? MF : HA) + (size_t)row * DM;
      const float* gate = modp + (mode == 1 ? 2048 : 5120);
      const float* na = p.norm_g + (size_t)(layer * 4 + (mode == 1 ? 1 : 3)) * DM;
      f32x4 mv[4]; float ss = 0.f;
#pragma unroll
      for (int i = 0; i < 4; ++i) { const u32x2 u = *(const u32x2*)(src + lane * 4 + 256 * i); mv[i] = (f32x4){bflo(u.x), bfhi(u.x), bflo(u.y), bfhi(u.y)};
        ss += mv[i][0] * mv[i][0] + mv[i][1] * mv[i][1] + mv[i][2] * mv[i][2] + mv[i][3] * mv[i][3]; }
      ss = wave_sum(ss);
      const float rstd = rsqrtf(ss * (1.f / DM) + EPS);
#pragma unroll
      for (int i = 0; i < 4; ++i) { const f32x4 g = *(const f32x4*)(gate + lane * 4 + 256 * i), n = *(const f32x4*)(na + lane * 4 + 256 * i);
        xv[i] = xv[i] + g * (mv[i] * rstd * n); }
      float* dst = (mode == 2 && layer == 1) ? p.out + ((size_t)b * T + pp - LC) * DM : X + (size_t)row * DM;
#pragma unroll
      for (int i = 0; i < 4; ++i) *(f32x4*)(dst + lane * 4 + 256 * i) = xv[i];
    }
    if (!(mode == 2 && layer == 1)) {
      const float* nb; const float* sh; const float* sc;
      if (mode == 0) { nb = p.norm_g + (size_t)(layer * 4 + 0) * DM; sh = modp; sc = modp + 1024; }
      else if (mode == 1) { nb = p.norm_g + (size_t)(layer * 4 + 2) * DM; sh = modp + 3072; sc = modp + 4096; }
      else { const float* modn = mod + (size_t)((layer + 1) * 9 + mi) * 6144; nb = p.norm_g + (size_t)((layer + 1) * 4 + 0) * DM; sh = modn; sc = modn + 1024; }
      float ss = 0.f;
#pragma unroll
      for (int i = 0; i < 4; ++i) ss += xv[i][0] * xv[i][0] + xv[i][1] * xv[i][1] + xv[i][2] * xv[i][2] + xv[i][3] * xv[i][3];
      ss = wave_sum(ss);
      const float rstd = rsqrtf(ss * (1.f / DM) + EPS);
      bf16_t* hd = HA + (size_t)row * DM;
#pragma unroll
      for (int i = 0; i < 4; ++i) { const f32x4 n = *(const f32x4*)(nb + lane * 4 + 256 * i), s1 = *(const f32x4*)(sc + lane * 4 + 256 * i), s0 = *(const f32x4*)(sh + lane * 4 + 256 * i);
        const f32x4 hv = (xv[i] * rstd * n) * (1.f + s1) + s0;
        *(u32x2*)(hd + lane * 4 + 256 * i) = (u32x2){pk2(hv[0], hv[1]), pk2(hv[2], hv[3])}; }
    }
  }
}

enum { EPI_PLAIN = 0, EPI_SQRELU = 1, EPI_INPROJ = 2 };
struct GemmDesc {
  const bf16_t* A; int lda; const bf16_t* Bt; int K; int NT; int SN; int nMT; int mt_off; int latent_map; int a_local; int c_local;
  int epi; int layer; bf16_t* C; int ldc;
};
DI void epi_inproj(const Params& p, int layer, int grow0, int n0, const f32x4 (&acc)[4][4], int wm, int wn, int r16, int q) {
  const int hc = (n0 >> 6) + wn;
  const bool even = (layer == 0);
  int kind, cidx;
  if (hc < 8) { kind = 0; cidx = hc; } else if (hc < 10) { kind = 1; cidx = hc - 8; } else if (hc < 12) { kind = 2; cidx = hc - 10; }
  else if (hc < 20) { kind = 0; cidx = hc - 12 + 8; } else if (hc < 28) { kind = 1; cidx = hc - 20 + 2; } else { kind = 2; cidx = hc - 28 + 2; }
  const bool do_norm = even && hc < 10;
  const bool do_rope = (hc < 10) || (even && hc >= 12 && hc < 28);
  const float qscale = (kind == 0) ? 0.125f * LOG2E : 1.f;
  const float* g = p.qk_norm_a + (hc < 8 ? 0 : 64);
  const float* rt = (const float*)(p.ws + OFF_ROPE);
  const int b = grow0 / P, p0 = grow0 - b * P;
  const bool latent = p0 >= LC;
  bf16_t* Qb = (bf16_t*)(p.ws + OFF_Q); bf16_t* Kb = (bf16_t*)(p.ws + OFF_K); bf16_t* Vt = (bf16_t*)(p.ws + OFF_VT);
#pragma unroll
  for (int mt = 0; mt < 4; ++mt) {
    const int rl = wm * 64 + mt * 16 + r16, pp = p0 + rl;
    f32x4 v[4];
#pragma unroll
    for (int nt = 0; nt < 4; ++nt) v[nt] = acc[mt][nt];
    if (do_norm) {
      float ss = 0.f;
#pragma unroll
      for (int nt = 0; nt < 4; ++nt) ss += v[nt][0] * v[nt][0] + v[nt][1] * v[nt][1] + v[nt][2] * v[nt][2] + v[nt][3] * v[nt][3];
      ss += __shfl_xor(ss, 16); ss += __shfl_xor(ss, 32);
      const float rstd = rsqrtf(ss * (1.f / 64.f) + EPS);
#pragma unroll
      for (int nt = 0; nt < 4; ++nt) { const f32x4 gv = *(const f32x4*)(g + nt * 16 + q * 4); v[nt] = v[nt] * rstd * gv; }
    }
    if (do_rope && latent) {
      const int tt = pp - LC, pr = tt >> 6, pc = tt & 63;
      const f32x4 c0 = *(const f32x4*)(rt + pr * 16 + q * 4), s0 = *(const f32x4*)(rt + 1024 + pr * 16 + q * 4);
      const f32x4 c1 = *(const f32x4*)(rt + pc * 16 + q * 4), s1 = *(const f32x4*)(rt + 1024 + pc * 16 + q * 4);
      const f32x4 a1 = v[0], a2 = v[1], b1 = v[2], b2 = v[3];
      v[0] = a1 * c0 - a2 * s0; v[1] = a2 * c0 + a1 * s0;
      v[2] = b1 * c1 - b2 * s1; v[3] = b2 * c1 + b1 * s1;
    }
    if (kind == 0) {
      bf16_t* d = Qb + (size_t)(grow0 + rl) * 1024 + cidx * 64 + q * 4;
#pragma unroll
      for (int nt = 0; nt < 4; ++nt) { const f32x4 o = v[nt] * qscale; *(u32x2*)(d + nt * 16) = (u32x2){pk2(o[0], o[1]), pk2(o[2], o[3])}; }
    } else if (kind == 1) {
      bf16_t* d = Kb + (size_t)(grow0 + rl) * 640 + cidx * 64 + q * 4;
#pragma unroll
      for (int nt = 0; nt < 4; ++nt) *(u32x2*)(d + nt * 16) = (u32x2){pk2(v[nt][0], v[nt][1]), pk2(v[nt][2], v[nt][3])};
    } else {
      bf16_t* d = Vt + ((size_t)(b * 10 + cidx) * 64 + q * 4) * P + pp;
#pragma unroll
      for (int nt = 0; nt < 4; ++nt) {
        const unsigned u0 = pk2(v[nt][0], v[nt][1]), u1 = pk2(v[nt][2], v[nt][3]);
        bf16_t* dd = d + (size_t)(nt * 16) * P;
        dd[0] = (bf16_t)(u0 & 0xffffu); dd[P] = (bf16_t)(u0 >> 16); dd[2 * P] = (bf16_t)(u1 & 0xffffu); dd[3 * P] = (bf16_t)(u1 >> 16);
      }
    }
  }
}
DI void phase_gemm(const Ctx& cx, const Params& p, const GemmDesc& g, unsigned char* lds) {
  const int t = cx.tid, lane = t & 63, w = t >> 6, wm = w >> 1, wn = w & 1, r16 = lane & 15, q = lane >> 4;
  const int srow = t >> 3, skc = t & 7;
  const unsigned sw0 = (unsigned)(srow * 128 + ((skc ^ ((srow >> 1) & 7)) << 4));
  const int sx = (r16 >> 1) & 7;
  const int total = g.nMT * g.NT, chunk = 8 * g.SN, nChunkN = g.NT / g.SN;
  const int xcd = cx.bid & 7, jb = cx.bid >> 3, J = cx.nb >> 3;
  const int nkt = g.K >> 6;
  for (int k = jb;; k += J) {
    const int cl = k / chunk, within = k - cl * chunk;
    const int lin = (cl * 8 + xcd) * chunk + within;
    if (lin >= total) break;
    const int c = lin / chunk, cm = c / nChunkN, cn = c - cm * nChunkN;
    const int mti = cm * 8 + (within & 7), nti = cn * g.SN + (within >> 3);
    const int jm = g.mt_off + mti;
    const int grt = g.latent_map ? ((jm >> 4) * 18 + 2 + (jm & 15)) : jm;
    const int a_row0 = g.a_local ? mti * 128 : grt * 128;
    const int c_row0 = g.c_local ? mti * 128 : grt * 128;
    const int n0 = nti * 128;
    const bf16_t* ag = g.A + (size_t)(a_row0 + srow) * g.lda + skc * 8;
    const bf16_t* bg = g.Bt + (size_t)(n0 + srow) * g.K + skc * 8;
    f32x4 acc[4][4];
#pragma unroll
    for (int i = 0; i < 4; ++i)
#pragma unroll
      for (int j = 0; j < 4; ++j) acc[i][j] = (f32x4){0.f, 0.f, 0.f, 0.f};
    u32x4 ra[4], rb[4];
#pragma unroll
    for (int i = 0; i < 4; ++i) { ra[i] = *(const u32x4*)(ag + (size_t)(32 * i) * g.lda); rb[i] = *(const u32x4*)(bg + (size_t)(32 * i) * g.K); }
#pragma unroll
    for (int i = 0; i < 4; ++i) { *(u32x4*)(lds + sw0 + 4096 * i) = ra[i]; *(u32x4*)(lds + 16384 + sw0 + 4096 * i) = rb[i]; }
    __syncthreads();
    for (int kt = 0; kt < nkt; ++kt) {
      const int buf = kt & 1;
      const bool more = (kt + 1 < nkt);
      if (more) {
#pragma unroll
        for (int i = 0; i < 4; ++i) { ra[i] = *(const u32x4*)(ag + (size_t)(32 * i) * g.lda + (kt + 1) * 64); rb[i] = *(const u32x4*)(bg + (size_t)(32 * i) * g.K + (kt + 1) * 64); }
      }
      const unsigned char* sa = lds + buf * 32768;
      const unsigned char* sb = sa + 16384;
#pragma unroll
      for (int ks = 0; ks < 2; ++ks) {
        bf16x8 af[4], bfr[4];
        const int co = ((ks * 4 + q) ^ sx) << 4;
#pragma unroll
        for (int mt = 0; mt < 4; ++mt) af[mt] = *(const bf16x8*)(sa + (wm * 64 + mt * 16 + r16) * 128 + co);
#pragma unroll
        for (int nt = 0; nt < 4; ++nt) bfr[nt] = *(const bf16x8*)(sb + (wn * 64 + nt * 16 + r16) * 128 + co);
#pragma unroll
        for (int mt = 0; mt < 4; ++mt)
#pragma unroll
          for (int nt = 0; nt < 4; ++nt) acc[mt][nt] = __builtin_amdgcn_mfma_f32_16x16x32_bf16(bfr[nt], af[mt], acc[mt][nt], 0, 0, 0);
      }
      if (more) {
        unsigned char* d = lds + (buf ^ 1) * 32768;
#pragma unroll
        for (int i = 0; i < 4; ++i) { *(u32x4*)(d + sw0 + 4096 * i) = ra[i]; *(u32x4*)(d + 16384 + sw0 + 4096 * i) = rb[i]; }
      }
      __syncthreads();
    }
    if (g.epi == EPI_INPROJ) {
      epi_inproj(p, g.layer, c_row0, n0, acc, wm, wn, r16, q);
    } else {
#pragma unroll
      for (int mt = 0; mt < 4; ++mt) {
        bf16_t* d = g.C + (size_t)(c_row0 + wm * 64 + mt * 16 + r16) * g.ldc + n0 + wn * 64 + q * 4;
#pragma unroll
        for (int nt = 0; nt < 4; ++nt) {
          f32x4 v = acc[mt][nt];
          if (g.epi == EPI_SQRELU) {
#pragma unroll
            for (int j = 0; j < 4; ++j) { const float r = v[j] > 0.f ? v[j] : 0.f; v[j] = r * r; }
          }
          *(u32x2*)(d + nt * 16) = (u32x2){pk2(v[0], v[1]), pk2(v[2], v[3])};
        }
      }
    }
  }
}

constexpr int VS_OFF = 16384, RPB_OFF = 16384 + 128 * 136;
template <int MODE>
DI void attn_item(const Ctx& cx, const Params& p, unsigned char* lds, int b, int h, int q0, int n0, int t1s, int t1e) {
  constexpr int NDB = (MODE == 1) ? 4 : 2;
  constexpr int NK = (MODE == 1) ? 2 : 1;
  const int t = cx.tid, lane = t & 63, w = t >> 6, r32 = lane & 31, hh = lane >> 5;
  const bf16_t* Qb = (const bf16_t*)(p.ws + OFF_Q); const bf16_t* Kb = (const bf16_t*)(p.ws + OFF_K); const bf16_t* Vt = (const bf16_t*)(p.ws + OFF_VT);
  bf16_t* Ob = (bf16_t*)(p.ws + OFF_A);
  int cq, ck, cv, kidx, qoff, ocol;
  if (MODE == 0 || MODE == 2) { cq = h; ck = h >> 2; cv = h >> 2; kidx = 0; qoff = 32 * w; ocol = h * 64; }
  else if (MODE == 3) { cq = 8 + h; ck = 2 + h; cv = 2 + h; kidx = 0; qoff = 32 * w; ocol = 512 + h * 64; }
  else { const int j = w >> 1; cq = 8 + 2 * h + j; ck = 2 + 2 * h; cv = 2 + 2 * h; kidx = j; qoff = 32 * (w & 1); ocol = 512 + h * 128; }
  const size_t rowbase = (size_t)b * P;
  const int qp = q0 + qoff + r32;
  bf16x8 qf[4];
  { const bf16_t* qptr = Qb + (rowbase + qp) * 1024 + cq * 64 + hh * 8;
#pragma unroll
    for (int ks = 0; ks < 4; ++ks) qf[ks] = *(const bf16x8*)(qptr + ks * 16); }
  float m_run = -1e30f, l_run = 0.f;
  if (MODE == 2) { m_run = p.sink_c[h] * LOG2E; l_run = 1.f; }
  f32x16 O[NDB];
#pragma unroll
  for (int db = 0; db < NDB; ++db)
#pragma unroll
    for (int i = 0; i < 16; ++i) O[db][i] = 0.f;
  __syncthreads();
  const float* rpbs = (const float*)(lds + RPB_OFF);
  if (MODE == 3) { float* rp = (float*)(lds + RPB_OFF); for (int i = t; i < 465; i += 256) rp[i] = p.rpb_d[h * 465 + i] * LOG2E; }
  const int srow = t >> 3, skc = t & 7;
  const unsigned ksw = (unsigned)(srow * 128 + ((skc ^ ((srow >> 1) & 7)) << 4));
  const int ksx = (r32 >> 1) & 7;
  u32x4 kreg[NK][2], vreg[NDB];
  const int ntl = n0 + (t1e - t1s);
  auto tile_of = [&](int i) { return i < n0 ? i : t1s + (i - n0); };
  auto prefetch = [&](int tile) {
    const size_t key0 = rowbase + (size_t)tile * 64;
#pragma unroll
    for (int kk = 0; kk < NK; ++kk)
#pragma unroll
      for (int i = 0; i < 2; ++i) kreg[kk][i] = *(const u32x4*)(Kb + (key0 + srow + 32 * i) * 640 + (ck + kk) * 64 + skc * 8);
#pragma unroll
    for (int i = 0; i < NDB; ++i) vreg[i] = *(const u32x4*)(Vt + ((size_t)(b * 10 + cv) * 64 + srow + 32 * i) * P + tile * 64 + skc * 8);
  };
  auto stage = [&]() {
#pragma unroll
    for (int kk = 0; kk < NK; ++kk)
#pragma unroll
      for (int i = 0; i < 2; ++i) *(u32x4*)(lds + kk * 8192 + ksw + 4096 * i) = kreg[kk][i];
#pragma unroll
    for (int i = 0; i < NDB; ++i) { unsigned char* d = lds + VS_OFF + (srow + 32 * i) * 136 + skc * 16;
      *(u32x2*)d = (u32x2){vreg[i].x, vreg[i].y}; *(u32x2*)(d + 8) = (u32x2){vreg[i].z, vreg[i].w}; }
  };
  const int qpos = qp - LC;
  const int qr = qpos >> 6, qc = qpos & 63;
  auto compute = [&](int tile) {
    int krow_ = 0;
    if (MODE == 3 && tile >= 4) { krow_ = tile - 4; const int rs = clampi(qr - 4, 0, 24); if (krow_ < rs || krow_ >= rs + 8) return; }
#pragma unroll 1
    for (int kt = 0; kt < 2; ++kt) {
      f32x16 S;
#pragma unroll
      for (int i = 0; i < 16; ++i) S[i] = 0.f;
#pragma unroll
      for (int ks = 0; ks < 4; ++ks) {
        const bf16x8 a = *(const bf16x8*)(lds + kidx * 8192 + (kt * 32 + r32) * 128 + (((2 * ks + hh) ^ ksx) << 4));
        S = __builtin_amdgcn_mfma_f32_32x32x16_bf16(a, qf[ks], S, 0, 0, 0);
      }
      if (MODE == 2 && tile >= 4) {
#pragma unroll
        for (int i = 0; i < 16; ++i) { const int d = (tile - 4) * 64 + kt * 32 + crow(i, hh) - qpos; if (d > 128 || d < -128) S[i] = -1e30f; }
      }
      if (MODE == 3 && tile >= 4) {
        const int cs = clampi(qc - 8, 0, 48);
        const float* rp = rpbs + (krow_ - qr + 7) * 31 + 15;
#pragma unroll
        for (int i = 0; i < 16; ++i) { const int kc = kt * 32 + crow(i, hh); const bool valid = (kc >= cs) && (kc < cs + 16); const int dc = clampi(kc - qc, -15, 15);
          S[i] = valid ? S[i] + rp[dc] : -1e30f; }
      }
      float mx = S[0];
#pragma unroll
      for (int i = 1; i < 16; ++i) mx = fmaxf(mx, S[i]);
      mx = fmaxf(mx, __shfl_xor(mx, 32));
      const float m_new = fmaxf(m_run, mx);
      const bool grew = m_new > m_run;
      const float alpha = __builtin_amdgcn_exp2f(m_run - m_new);
      float ps = 0.f;
#pragma unroll
      for (int i = 0; i < 16; ++i) { const float pv = __builtin_amdgcn_exp2f(S[i] - m_new); S[i] = pv; ps += pv; }
      ps += __shfl_xor(ps, 32);
      l_run = l_run * alpha + ps; m_run = m_new;
      if (__builtin_amdgcn_ballot_w64(grew) != 0ull) {
#pragma unroll
        for (int db = 0; db < NDB; ++db)
#pragma unroll
          for (int i = 0; i < 16; ++i) O[db][i] *= alpha;
      }
      bf16x8 pf[2];
#pragma unroll
      for (int s = 0; s < 2; ++s) {
        u32x4 u; u.x = pk2(S[8 * s + 0], S[8 * s + 1]); u.y = pk2(S[8 * s + 2], S[8 * s + 3]); u.z = pk2(S[8 * s + 4], S[8 * s + 5]); u.w = pk2(S[8 * s + 6], S[8 * s + 7]);
        pf[s] = __builtin_bit_cast(bf16x8, u);
      }
#pragma unroll
      for (int db = 0; db < NDB; ++db)
#pragma unroll
        for (int s = 0; s < 2; ++s) {
          const unsigned char* vb = lds + VS_OFF + (db * 32 + r32) * 136 + (kt * 32 + 16 * s + 4 * hh) * 2;
          const s16x4 lo = *(const s16x4*)vb, hi = *(const s16x4*)(vb + 16);
          const bf16x8 a = __builtin_shufflevector(lo, hi, 0, 1, 2, 3, 4, 5, 6, 7);
          O[db] = __builtin_amdgcn_mfma_f32_32x32x16_bf16(a, pf[s], O[db], 0, 0, 0);
        }
    }
  };
  prefetch(tile_of(0));
  for (int i = 0; i < ntl; ++i) {
    __syncthreads();
    stage();
    __syncthreads();
    if (i + 1 < ntl) prefetch(tile_of(i + 1));
    compute(tile_of(i));
  }
  const float inv = 1.f / l_run;
  bf16_t* orow = Ob + (rowbase + qp) * 1024 + ocol;
  if (MODE != 1) {
#pragma unroll
    for (int db = 0; db < NDB; ++db)
#pragma unroll
      for (int g = 0; g < 4; ++g) {
        const int dv = db * 32 + 8 * g + 4 * hh;
        *(u32x2*)(orow + dv) = (u32x2){pk2(O[db][4 * g] * inv, O[db][4 * g + 1] * inv), pk2(O[db][4 * g + 2] * inv, O[db][4 * g + 3] * inv)};
      }
  } else {
    const float* lp = p.diff_lambda;
    float s1 = lp[lane] * lp[64 + lane], s2 = lp[128 + lane] * lp[192 + lane];
    s1 = wave_sum(s1); s2 = wave_sum(s2);
    const float lam = __expf(s1) - __expf(s2) + 0.2f;
    float* xch = (float*)lds;
    __syncthreads();
    if (w >= 2) {
#pragma unroll
      for (int db = 0; db < NDB; ++db)
#pragma unroll
        for (int i = 0; i < 16; ++i) xch[(db * 32 + crow(i, hh)) * 64 + qoff + r32] = O[db][i] * inv;
    }
    __syncthreads();
    if (w < 2) {
      float ss = 0.f;
#pragma unroll
      for (int db = 0; db < NDB; ++db)
#pragma unroll
        for (int i = 0; i < 16; ++i) { const float o = O[db][i] * inv - lam * xch[(db * 32 + crow(i, hh)) * 64 + qoff + r32]; O[db][i] = o; ss += o * o; }
      ss += __shfl_xor(ss, 32);
      const float rstd = rsqrtf(ss * (1.f / 128.f) + EPS) * 0.8f;
#pragma unroll
      for (int db = 0; db < NDB; ++db)
#pragma unroll
        for (int g = 0; g < 4; ++g) {
          const int dv = db * 32 + 8 * g + 4 * hh;
          const f32x4 sg = *(const f32x4*)(p.diff_subln + dv);
          *(u32x2*)(orow + dv) = (u32x2){pk2(O[db][4 * g] * rstd * sg[0], O[db][4 * g + 1] * rstd * sg[1]), pk2(O[db][4 * g + 2] * rstd * sg[2], O[db][4 * g + 3] * rstd * sg[3])};
        }
    }
  }
}
DI void phase_attn(const Ctx& cx, const Params& p, int layer, unsigned char* lds) {
  const int total = (layer == 0) ? 2304 : 2048;
  for (int idx = cx.bid; idx < total; idx += cx.nb) {
    int mode, b, h, q0, n0 = 4, t1s = 0, t1e = 0;
    if (layer == 0) {
      if (idx < 1024) { mode = 0; const int qb = idx & 15; h = (idx >> 4) & 7; b = idx >> 7; q0 = LC + qb * 128; n0 = 36; }
      else if (idx < 2048) { const int i = idx - 1024; mode = 1; const int qb = i & 31; h = (i >> 5) & 3; b = i >> 7; q0 = LC + qb * 64; n0 = 36; }
      else if (idx < 2176) { const int i = idx - 2048; mode = 0; const int qb = i & 1; h = (i >> 1) & 7; b = i >> 4; q0 = qb * 128; }
      else { const int i = idx - 2176; mode = 1; const int qb = i & 3; h = (i >> 2) & 3; b = i >> 4; q0 = qb * 64; }
    } else {
      const int i = idx & 1023; const int qb = i & 15; h = (i >> 4) & 7; b = i >> 7; q0 = LC + qb * 128;
      if (idx < 1024) { mode = 3; t1s = 4 + clampi(2 * qb - 4, 0, 24); t1e = 4 + clampi(2 * qb - 3, 0, 24) + 8; }
      else { mode = 2; t1s = 4 + (2 * qb - 2 > 0 ? 2 * qb - 2 : 0); t1e = 4 + (2 * qb + 4 < 32 ? 2 * qb + 4 : 32); }
    }
    if (mode == 0) attn_item<0>(cx, p, lds, b, h, q0, n0, t1s, t1e);
    else if (mode == 1) attn_item<1>(cx, p, lds, b, h, q0, n0, t1s, t1e);
    else if (mode == 2) attn_item<2>(cx, p, lds, b, h, q0, n0, t1s, t1e);
    else attn_item<3>(cx, p, lds, b, h, q0, n0, t1s, t1e);
  }
}

constexpr int NPH = 22;
DI void run_phase(const Ctx& cx, const Params& p, int ph, unsigned char* lds) {
  bf16_t* WIN = (bf16_t*)(p.ws + OFF_WIN); bf16_t* WOUT = (bf16_t*)(p.ws + OFF_WOUT); bf16_t* W1 = (bf16_t*)(p.ws + OFF_W1); bf16_t* W2 = (bf16_t*)(p.ws + OFF_W2);
  bf16_t* RA = (bf16_t*)(p.ws + OFF_A); bf16_t* RB = (bf16_t*)(p.ws + OFF_B);
  if (ph == 0) { phase_prep(cx, p, lds); return; }
  if (ph == 1) { phase_rowpass(cx, p, 0, 0); return; }
  const int layer = ph >= 13 ? 1 : 0;
  const int lp = ph - (layer ? 13 : 2);
  GemmDesc g{}; g.layer = layer;
  if (lp == 0) {
    g.A = RA; g.lda = DM; g.Bt = WIN + (size_t)layer * INW * DM; g.K = DM; g.NT = 18; g.SN = 6; g.nMT = 144; g.mt_off = 0; g.latent_map = 0; g.a_local = 0; g.c_local = 0; g.epi = EPI_INPROJ; g.C = nullptr; g.ldc = 0;
    phase_gemm(cx, p, g, lds); return;
  }
  if (lp == 1) { phase_attn(cx, p, layer, lds); return; }
  if (lp == 2) {
    g.A = RA; g.lda = DM; g.Bt = WOUT + (size_t)layer * DM * DM; g.K = DM; g.NT = 8; g.SN = 8; g.nMT = layer ? 128 : 144; g.mt_off = 0; g.latent_map = layer; g.a_local = 0; g.c_local = 0; g.epi = EPI_PLAIN; g.C = RB; g.ldc = DM;
    phase_gemm(cx, p, g, lds); return;
  }
  if (lp == 3) { phase_rowpass(cx, p, 1, layer); return; }
  const int nmlp = layer ? 4 : 6;
  if (lp < 4 + nmlp) {
    const int pass = (lp - 4) >> 1, isdown = (lp - 4) & 1;
    const int mt_off = pass * 64, nmt = (layer == 0 && pass == 2) ? 16 : 64;
    g.nMT = nmt; g.mt_off = mt_off; g.latent_map = layer; g.SN = 8;
    if (!isdown) { g.A = RA; g.lda = DM; g.Bt = W1 + (size_t)layer * FF * DM; g.K = DM; g.NT = 32; g.a_local = 0; g.c_local = 1; g.epi = EPI_SQRELU; g.C = RB; g.ldc = FF; }
    else { g.A = RB; g.lda = FF; g.Bt = W2 + (size_t)layer * DM * FF; g.K = FF; g.NT = 8; g.a_local = 1; g.c_local = 0; g.epi = EPI_PLAIN; g.C = RA; g.ldc = DM; }
    phase_gemm(cx, p, g, lds); return;
  }
  phase_rowpass(cx, p, 2, layer);
}

__global__ void __launch_bounds__(256, 2) fwd_megakernel(Params p) {
  __shared__ __attribute__((aligned(16))) unsigned char smem[65536];
  cg::grid_group grid = cg::this_grid();
  XcdBarrier xb; xb.bar = (unsigned*)(p.ws + OFF_BAR); xb.x = xb_xcc_id(); xb.nloc = 0u; xb.nx = 0u;
  if (threadIdx.x == 0) (void)xb_add(&xb.bar[XB_XCNT(xb.x)], 1u);
  for (int ph = 0; ph < NPH; ++ph) {
    Ctx cx; cx.tid = threadIdx.x; cx.bid = blockIdx.x; cx.nb = gridDim.x;
    asm volatile("" : "+v"(cx.tid)); asm volatile("" : "+s"(cx.bid));
    Params q = p; asm volatile("" : "+s"(q.ws));
    run_phase(cx, q, ph, smem);
    if (ph == 0) grid.sync();
    else if (ph + 1 < NPH) xcd_barrier(xb);
  }
}
__global__ void __launch_bounds__(256, 2) phase_kernel(Params p, int ph) {
  __shared__ __attribute__((aligned(16))) unsigned char smem[65536];
  Ctx cx; cx.tid = threadIdx.x; cx.bid = blockIdx.x; cx.nb = gridDim.x;
  run_phase(cx, p, ph, smem);
}

extern "C" void kernel_launch(void* const* d_in, const int* in_sizes, int n_in, void* d_out, int out_size, void* d_ws, size_t ws_size, hipStream_t stream) {
  Params p{};
  p.x = (const float*)d_in[0]; p.c = (const float*)d_in[1]; p.ctx = (const float*)d_in[2]; p.c_ctx = (const float*)d_in[3];
  p.w_mod = (const float*)d_in[4]; p.b_mod = (const float*)d_in[5]; p.norm_g = (const float*)d_in[6]; p.w_in = (const float*)d_in[7];
  p.w_out = (const float*)d_in[8]; p.w_mlp_in = (const float*)d_in[9]; p.w_mlp_out = (const float*)d_in[10]; p.qk_norm_a = (const float*)d_in[11];
  p.diff_lambda = (const float*)d_in[12]; p.diff_subln = (const float*)d_in[13]; p.sink_c = (const float*)d_in[14]; p.rpb_d = (const float*)d_in[15];
  p.out = (float*)d_out; p.ws = (unsigned char*)d_ws;
  if (ws_size < WS_END) { fprintf(stderr, "workspace too small: %zu < %zu\n", ws_size, (size_t)WS_END); return; }
#if MULTI
  for (int ph = 0; ph < NPH; ++ph) phase_kernel<<<dim3(512), dim3(256), 0, stream>>>(p, ph);
#else
  static int grid_blocks = 0;
  if (!grid_blocks) {
    int dev = 0, cus = 0, per_cu = 0;
    hipGetDevice(&dev);
    hipDeviceGetAttribute(&cus, hipDeviceAttributeMultiprocessorCount, dev);
    hipOccupancyMaxActiveBlocksPerMultiprocessor(&per_cu, fwd_megakernel, 256, 0);
    if (per_cu > 2) per_cu = 2;
    if (per_cu < 1) per_cu = 1;
    grid_blocks = cus * per_cu;
  }
  hipMemsetAsync(d_ws, 0, 16384, stream);
  void* args[] = {&p};
  hipError_t e = hipLaunchCooperativeKernel((void*)fwd_megakernel, dim3(grid_blocks), dim3(256), args, 0, stream);
  if (e != hipSuccess) fprintf(stderr, "cooperative launch failed: %s (grid %d)\n", hipGetErrorString(e), grid_blocks);
#endif
}
```

```cpp
#include <hip/hip_runtime.h>
#include <hip/hip_cooperative_groups.h>
#include <cstdint>
#include <cstdio>
namespace cg = cooperative_groups;

#ifndef MULTI
#define MULTI 0
#endif

#define DI __device__ __forceinline__
typedef unsigned short bf16_t;
typedef short bf16x8 __attribute__((ext_vector_type(8)));
typedef short s16x4 __attribute__((ext_vector_type(4)));
typedef float f32x2 __attribute__((ext_vector_type(2)));
typedef float f32x4 __attribute__((ext_vector_type(4)));
typedef float f32x16 __attribute__((ext_vector_type(16)));
typedef unsigned u32x2 __attribute__((ext_vector_type(2)));
typedef unsigned u32x4 __attribute__((ext_vector_type(4)));
typedef __bf16 bf16x2_t __attribute__((ext_vector_type(2)));

constexpr int NB = 8, T = 2048, LC = 256, P = 2304, R = NB * P, DM = 1024, INW = 2304, FF = 4096;
constexpr int NTHR = 512, NWV = 8;
constexpr int LDS_BYTES = 131072;
constexpr float EPS = 1e-6f;
constexpr float LOG2E = 1.4426950408889634f;

constexpr size_t OFF_BAR = 0;
constexpr size_t OFF_MOD = 16384;
constexpr size_t OFF_ROPE = OFF_MOD + 2 * 9 * 6144 * 4;
constexpr size_t OFF_W1 = 524288;
constexpr size_t OFF_W2 = OFF_W1 + (size_t)FF * DM * 2;
constexpr size_t OFF_X = OFF_W2 + (size_t)FF * DM * 2;
constexpr size_t OFF_A = OFF_X + (size_t)R * DM * 4;
constexpr size_t OFF_WIN = OFF_A + (size_t)R * DM * 2;
constexpr size_t OFF_WOUT = OFF_WIN + (size_t)INW * DM * 2;
constexpr size_t OFF_B = OFF_WOUT + (size_t)DM * DM * 2;
constexpr size_t OFF_Q = OFF_B;
constexpr size_t OFF_K = OFF_Q + (size_t)R * DM * 2;
constexpr size_t OFF_VT = OFF_K + (size_t)R * 640 * 2;
constexpr size_t OFF_U = OFF_WIN;
constexpr size_t WS_END = OFF_U + (size_t)16384 * FF * 2;
static_assert(OFF_VT + (size_t)R * 640 * 2 <= WS_END && WS_END <= 268435456ull, "workspace map");

struct Params {
  const float *x, *c, *ctx, *c_ctx, *w_mod, *b_mod, *norm_g, *w_in, *w_out, *w_mlp_in, *w_mlp_out, *qk_norm_a, *diff_lambda, *diff_subln, *sink_c, *rpb_d;
  float* out;
  unsigned char* ws;
};

struct Ctx { int tid, bid, nb; };
DI unsigned pk2(float lo, float hi) { f32x2 v = {lo, hi}; return __builtin_bit_cast(unsigned, __builtin_convertvector(v, bf16x2_t)); }
DI float bflo(unsigned u) { return __uint_as_float(u << 16); }
DI float bfhi(unsigned u) { return __uint_as_float(u & 0xffff0000u); }
DI int clampi(int v, int lo, int hi) { return v < lo ? lo : (v > hi ? hi : v); }
DI int crow(int i, int hh) { return (i & 3) + 8 * (i >> 2) + 4 * hh; }

#define XB_TMO      128
#define XB_XCNT(j)  (256  + 64 * (j))
#define XB_XSUB(j)  (1280 + 64 * (j))
#define XB_XGEN(j)  (2304 + 64 * (j))
#define XB_TOP      3328
#define XB_TOPGEN   3392
#define XCD_BAR_WORDS 3456
#define XB_SPIN_CAP (1u << 20)
DI unsigned xb_ld(unsigned* p) { return __hip_atomic_load(p, __ATOMIC_RELAXED, __HIP_MEMORY_SCOPE_AGENT); }
DI unsigned xb_add(unsigned* p, unsigned v) { return __hip_atomic_fetch_add(p, v, __ATOMIC_RELAXED, __HIP_MEMORY_SCOPE_AGENT); }
DI unsigned xb_xcc_id() { return (unsigned)__builtin_amdgcn_s_getreg((3 << 11) | 20) & 0xFu; }
#define XB_SPIN(cond, bar) do { unsigned _sp = 0; while (cond) { __builtin_amdgcn_s_sleep(1); \
    if ((++_sp & 255u) == 0u) { if (xb_ld(&(bar)[XB_TMO])) break; if (_sp > XB_SPIN_CAP) { atomicAdd(&(bar)[XB_TMO], 1u); break; } } } } while (0)
struct XcdBarrier { unsigned* bar; unsigned x; unsigned nloc, nx; };
DI void xcd_barrier_complete(unsigned* bar, unsigned x, unsigned& nloc, unsigned& nx) {
  const unsigned G = gridDim.x * gridDim.y * gridDim.z;
  unsigned sum, cnt, mine, sp = 0u;
  for (;;) {
    sum = 0u; cnt = 0u; mine = 0u;
#pragma unroll
    for (unsigned j = 0; j < 16; ++j) { const unsigned c = xb_ld(&bar[XB_XCNT(j)]); sum += c; cnt += (c > 0u) ? 1u : 0u; mine = (j == x) ? c : mine; }
    if (sum == G) break;
    __builtin_amdgcn_s_sleep(1);
    if ((++sp & 255u) == 0u) { if (xb_ld(&bar[XB_TMO])) break; if (sp > XB_SPIN_CAP) { atomicAdd(&bar[XB_TMO], 1u); break; } }
  }
  nloc = mine > 0u ? mine : 1u; nx = cnt > 0u ? cnt : 1u;
}
DI void xcd_barrier(XcdBarrier& b) {
  asm volatile("s_waitcnt vmcnt(0)" ::: "memory");
  __syncthreads();
  if (threadIdx.x == 0) {
    unsigned* bar = b.bar;
    __builtin_amdgcn_s_waitcnt(0);
    if (b.nloc == 0u) xcd_barrier_complete(bar, b.x, b.nloc, b.nx);
    const unsigned nloc = b.nloc, nx = b.nx;
    const unsigned old = xb_add(&bar[XB_XSUB(b.x)], 1u);
    const unsigned gen = old / nloc;
    if (old + 1u == (gen + 1u) * nloc) {
      __builtin_amdgcn_fence(__ATOMIC_RELEASE, "agent");
      asm volatile("s_waitcnt vmcnt(0)" ::: "memory");
      const unsigned og = xb_add(&bar[XB_TOP], 1u);
      const unsigned tg = og / nx;
      if (og + 1u == (tg + 1u) * nx) xb_add(&bar[XB_TOPGEN], 1u);
      else XB_SPIN(xb_ld(&bar[XB_TOPGEN]) == tg, bar);
      __builtin_amdgcn_fence(__ATOMIC_ACQUIRE, "agent");
      xb_add(&bar[XB_XGEN(b.x)], 1u);
      asm volatile("s_waitcnt vmcnt(0)" ::: "memory");
    } else {
      XB_SPIN(xb_ld(&bar[XB_XGEN(b.x)]) == gen, bar);
      __builtin_amdgcn_fence(__ATOMIC_ACQUIRE, "agent");
      asm volatile("s_waitcnt vmcnt(0)" ::: "memory");
    }
  }
  __syncthreads();
}

namespace pg8 {
#define PG8_LAS __attribute__((address_space(3)))
constexpr int BM = 256, BK = 64, HALF = 128, HTB = HALF * BK * 2  , STAGE_BYTES = 8 * HTB, NXCD = 8, WGM = 8;
__host__ __device__ __forceinline__ int lds_byte(int r, int c) { const int st = (r >> 4) * 2 + (c >> 5), rr = r & 15, cc = c & 31, ob = rr * 64 + cc * 2; return st * 1024 + (ob ^ (((ob >> 9) & 1) << 5)); }
__host__ __device__ __forceinline__ void stage_rc(int b, int& R, int& C) { const int st = b / 1024, sb = b % 1024, swz = sb ^ (((sb >> 9) & 1) << 5); R = (st >> 1) * 16 + swz / 64; C = (st & 1) * 32 + (swz % 64) / 2; }
__host__ __device__ __forceinline__ int perm32(int rho) { const int n = rho >> 4, i = rho & 15; return 8 * (i >> 2) + 4 * n + (i & 3); }

struct Unit { int pm, pn, pa; };
struct Gemm { const bf16_t* A; const bf16_t* Bt; int M, N, K; };

struct StaticOrder {
    int nM, nN, nwg, G, c, map, a_local, c_local;
    __device__ void init(int nMt, int nNt, int G_, int c_, int map_, int a_local_, int c_local_) { nM = nMt; nN = nNt; nwg = nM * nN; G = G_; c = c_; map = map_; a_local = a_local_; c_local = c_local_; }
    __device__ bool next(int i, Unit& u) const {
        const long L = (long)i * G + c; if (L >= nwg) return false;
        int wgid = (int)L; { const int q = nwg / NXCD, r = nwg % NXCD, xcd = wgid % NXCD, off = wgid / NXCD; wgid = (xcd < r ? xcd * (q + 1) : r * (q + 1) + (xcd - r) * q) + off; }
        const int nig = WGM * nN, gid = wgid / nig, fm = gid * WGM, gsz = (nM - fm) < WGM ? (nM - fm) : WGM;
        const int mi = fm + ((wgid % nig) % gsz); u.pn = (wgid % nig) / gsz;
        const int gt = map == 0 ? mi : (map == 1 ? ((mi >> 3) * 9 + 1 + (mi & 7)) : mi * 9);
        u.pa = a_local ? mi : gt; u.pm = c_local ? mi : gt; return true;
    }
    __device__ __forceinline__ void a_ready(const Unit&) const {}
    __device__ __forceinline__ void done(const Unit&) const {}
};

template <int ACT  > struct EpiBf16 {
    static constexpr bool PERM = true, AFTER_DRAIN = false;
    bf16_t* O; int ldc;
    __device__ __forceinline__ void operator()(const f32x4 (&acc)[2][2][4][2], const Unit& u, int wr, int wc, int fr, int fq) const {
        const int row0 = u.pm * BM + wr * 64 + fr; const int col0 = u.pn * BM + wc * 32 + 8 * fq;
#pragma unroll
        for (int ai = 0; ai < 2; ++ai)
#pragma unroll
            for (int m = 0; m < 4; ++m) { bf16_t* rowp = O + (size_t)(row0 + ai * HALF + m * 16) * ldc + col0;
#pragma unroll
                for (int bj = 0; bj < 2; ++bj) { f32x4 v0 = acc[ai][bj][m][0], v1 = acc[ai][bj][m][1];
                    if (ACT == 2) {
#pragma unroll
                        for (int j = 0; j < 4; ++j) { const float a = v0[j] > 0.f ? v0[j] : 0.f, b = v1[j] > 0.f ? v1[j] : 0.f; v0[j] = a * a; v1[j] = b * b; } }
                    u32x4 w; w.x = pk2(v0[0], v0[1]); w.y = pk2(v0[2], v0[3]); w.z = pk2(v1[0], v1[1]); w.w = pk2(v1[2], v1[3]);
                    *(u32x4*)(rowp + bj * HALF) = w; } }
    }
};
struct EpiInproj {
    static constexpr bool PERM = false, AFTER_DRAIN = false;
    const float* qk_g; const float* rt; bf16_t* Qb; bf16_t* Kb; bf16_t* Vt; int layer;
    __device__ __forceinline__ void operator()(const f32x4 (&acc)[2][2][4][2], const Unit& u, int wr, int wc, int fr, int fq) const {
        asm volatile("" : "+v"(fr), "+v"(fq));
        const int hc = 4 * u.pn + wc;
        const bool even = (layer == 0);
        int kind, cidx;
        if (hc < 8) { kind = 0; cidx = hc; } else if (hc < 10) { kind = 1; cidx = hc - 8; } else if (hc < 12) { kind = 2; cidx = hc - 10; }
        else if (hc < 20) { kind = 0; cidx = hc - 12 + 8; } else if (hc < 28) { kind = 1; cidx = hc - 20 + 2; } else { kind = 2; cidx = hc - 28 + 2; }
        const bool do_norm = even && hc < 10;
        const bool do_rope = (hc < 10) || (even && hc >= 12 && hc < 28);
        const float qscale = (kind == 0) ? 0.125f * LOG2E : 1.f;
        const float* g = qk_g + (hc < 8 ? 0 : 64);
        const int grow0 = u.pm * BM;
        const int b = grow0 / P, p0 = grow0 - b * P;
        const bool latent = p0 >= LC;
#pragma unroll
        for (int ai = 0; ai < 2; ++ai)
#pragma unroll
        for (int m = 0; m < 4; ++m) {
            const int rl = ai * HALF + wr * 64 + m * 16 + fr, pp = p0 + rl;
            f32x4 v[4];
#pragma unroll
            for (int nt = 0; nt < 4; ++nt) v[nt] = acc[ai][nt >> 1][m][nt & 1];
            if (do_norm) {
                float ss = 0.f;
#pragma unroll
                for (int nt = 0; nt < 4; ++nt) ss += v[nt][0] * v[nt][0] + v[nt][1] * v[nt][1] + v[nt][2] * v[nt][2] + v[nt][3] * v[nt][3];
                ss += __shfl_xor(ss, 16); ss += __shfl_xor(ss, 32);
                const float rstd = rsqrtf(ss * (1.f / 64.f) + EPS);
#pragma unroll
                for (int nt = 0; nt < 4; ++nt) { const f32x4 gv = *(const f32x4*)(g + nt * 16 + fq * 4); v[nt] = v[nt] * rstd * gv; }
            }
            if (do_rope && latent) {
                const int tt = pp - LC, pr = tt >> 6, pc = tt & 63;
                const f32x4 c0 = *(const f32x4*)(rt + pr * 16 + fq * 4), s0 = *(const f32x4*)(rt + 1024 + pr * 16 + fq * 4);
                const f32x4 c1 = *(const f32x4*)(rt + pc * 16 + fq * 4), s1 = *(const f32x4*)(rt + 1024 + pc * 16 + fq * 4);
                const f32x4 a1 = v[0], a2 = v[1], b1 = v[2], b2 = v[3];
                v[0] = a1 * c0 - a2 * s0; v[1] = a2 * c0 + a1 * s0;
                v[2] = b1 * c1 - b2 * s1; v[3] = b2 * c1 + b1 * s1;
            }
            if (kind == 0) {
                bf16_t* d = Qb + (size_t)(grow0 + rl) * 1024 + cidx * 64 + fq * 4;
#pragma unroll
                for (int nt = 0; nt < 4; ++nt) { const f32x4 o = v[nt] * qscale; *(u32x2*)(d + nt * 16) = (u32x2){pk2(o[0], o[1]), pk2(o[2], o[3])}; }
            } else if (kind == 1) {
                bf16_t* d = Kb + (size_t)(grow0 + rl) * 640 + cidx * 64 + fq * 4;
#pragma unroll
                for (int nt = 0; nt < 4; ++nt) *(u32x2*)(d + nt * 16) = (u32x2){pk2(v[nt][0], v[nt][1]), pk2(v[nt][2], v[nt][3])};
            } else {
                bf16_t* d = Vt + ((size_t)(b * 10 + cidx) * 64 + fq * 4) * P + pp;
#pragma unroll
                for (int nt = 0; nt < 4; ++nt) {
                    const unsigned u0 = pk2(v[nt][0], v[nt][1]), u1 = pk2(v[nt][2], v[nt][3]);
                    bf16_t* dd = d + (size_t)(nt * 16) * P;
                    dd[0] = (bf16_t)(u0 & 0xffffu); dd[P] = (bf16_t)(u0 >> 16); dd[2 * P] = (bf16_t)(u1 & 0xffffu); dd[3 * P] = (bf16_t)(u1 >> 16);
                }
            }
            asm volatile("" ::: "memory");
        }
    }
};
template <class Epi, class Sched, bool ALIGN_EPI = false, bool SP2 = false>
__device__ __forceinline__ void gemm_phase(PG8_LAS unsigned char* lds, const Gemm g, const Sched& S, const Epi& E, const int tid) {
    const int wid = __builtin_amdgcn_readfirstlane(tid >> 6), lane = tid & 63, wr = wid >> 2, wc = wid & 3, fr = lane & 15, fq = lane >> 4;
    const int K = g.K, nt = K / BK;
    unsigned voffA[2], voffB[2];
#pragma unroll
    for (int i = 0; i < 2; ++i) { int R, C; stage_rc(tid * 16 + i * 8192, R, C); const int Rb = Epi::PERM ? ((R & ~31) + perm32(R & 31)) : R;
        voffA[i] = (unsigned)(R * K + C) * 2u; voffB[i] = (unsigned)(Rb * K + C) * 2u; }
    const size_t kstep = (size_t)(BK * 2);
    const size_t hstep = (size_t)HALF * K * 2;
    const size_t tstep = 2 * hstep;
    const unsigned ldsw = (unsigned)wid * 1024u;
    const int aoff = lds_byte(wr * 64 + fr, fq * 8), boff = lds_byte(wc * 32 + fr, fq * 8);
#define PG8_SA(b, h) (((b) * 2 + (h)) * HTB)
#define PG8_SB(b, h) ((4 + (b) * 2 + (h)) * HTB)
#define PG8_STAGE(bufoff, gbase, voff) do { _Pragma("unroll") for (int _i = 0; _i < 2; ++_i) \
        __builtin_amdgcn_global_load_lds((const unsigned*)((const char*)(gbase) + (voff)[_i]), (PG8_LAS unsigned*)(lds + (bufoff) + ldsw + _i * 8192), 16, 0, 0); } while (0)
#define PG8_LDA(dst, b, h) do { _Pragma("unroll") for (int m = 0; m < 4; ++m) _Pragma("unroll") for (int k = 0; k < 2; ++k) dst[m][k] = *(const PG8_LAS bf16x8*)(lds + PG8_SA(b, h) + aoff + m * 2048 + k * 1024); } while (0)
#define PG8_LDB(dst, b, h) do { _Pragma("unroll") for (int n = 0; n < 2; ++n) _Pragma("unroll") for (int k = 0; k < 2; ++k) dst[n][k] = *(const PG8_LAS bf16x8*)(lds + PG8_SB(b, h) + boff + n * 2048 + k * 1024); } while (0)
#define PG8_MMA(ai, bj, At, Bt) do { __builtin_amdgcn_s_setprio(1); _Pragma("unroll") for (int m = 0; m < 4; ++m) _Pragma("unroll") for (int n = 0; n < 2; ++n) _Pragma("unroll") for (int k = 0; k < 2; ++k) \
        acc[ai][bj][m][n] = __builtin_amdgcn_mfma_f32_16x16x32_bf16(Bt[n][k], At[m][k], acc[ai][bj][m][n], 0, 0, 0); __builtin_amdgcn_s_setprio(0); } while (0)
#define PG8_WAIT_V(n) asm volatile("s_waitcnt vmcnt(" #n ")" ::: "memory")
#define PG8_WAIT_L(n) asm volatile("s_waitcnt lgkmcnt(" #n ")" ::: "memory")
#define PG8_BAR __builtin_amdgcn_s_barrier()
#define PG8_SCHED __builtin_amdgcn_sched_barrier(0)
    Unit cur, nxt; int ui = 0;
    if (!S.next(0, cur)) return;
    f32x4 acc[2][2][4][2];
#pragma unroll
    for (int a = 0; a < 2; ++a)
#pragma unroll
        for (int b = 0; b < 2; ++b)
#pragma unroll
            for (int m = 0; m < 4; ++m)
#pragma unroll
                for (int n = 0; n < 2; ++n) acc[a][b][m][n] = (f32x4){0.f, 0.f, 0.f, 0.f};
    bf16x8 At[4][2], B0[2][2], B1[2][2];
    const char* cA = (const char*)g.A + (size_t)cur.pa * tstep; const char* cB = (const char*)g.Bt + (size_t)cur.pn * tstep;
    S.a_ready(cur);
    if constexpr (SP2) {
        PG8_STAGE(PG8_SB(0, 0), cB, voffB); PG8_STAGE(PG8_SB(0, 1), cB + hstep, voffB); PG8_STAGE(PG8_SA(0, 0), cA, voffA); PG8_STAGE(PG8_SA(0, 1), cA + hstep, voffA);
        if (wr == 1) PG8_BAR;
        PG8_WAIT_V(2); PG8_BAR;
        PG8_STAGE(PG8_SB(1, 0), cB + kstep, voffB); PG8_STAGE(PG8_SA(1, 0), cA + kstep, voffA); PG8_STAGE(PG8_SB(1, 1), cB + hstep + kstep, voffB);
        PG8_WAIT_V(6); PG8_BAR;
    } else {
        PG8_STAGE(PG8_SB(0, 0), cB, voffB); PG8_STAGE(PG8_SA(0, 0), cA, voffA); PG8_STAGE(PG8_SB(0, 1), cB + hstep, voffB); PG8_STAGE(PG8_SA(0, 1), cA + hstep, voffA);
        if (wr == 1) PG8_BAR;
        PG8_WAIT_V(4); PG8_BAR;
        PG8_STAGE(PG8_SB(1, 0), cB + kstep, voffB); PG8_STAGE(PG8_SA(1, 0), cA + kstep, voffA); PG8_STAGE(PG8_SB(1, 1), cB + hstep + kstep, voffB);
        PG8_WAIT_V(6); PG8_BAR;
    }
    for (;;) {
        const bool has_next = S.next(ui + 1, nxt);
        const char* nA = has_next ? (const char*)g.A + (size_t)nxt.pa * tstep : cA; const char* nB = has_next ? (const char*)g.Bt + (size_t)nxt.pn * tstep : cB;
        for (int t = 0; t < nt; t += 2) {
            const bool last = (t == nt - 2);
            const char* a1 = cA + (size_t)(t + 1) * kstep;
            const char* a2 = last ? nA : cA + (size_t)(t + 2) * kstep; const char* b2 = last ? nB : cB + (size_t)(t + 2) * kstep;
            const char* a3 = a2 + kstep; const char* b3 = b2 + kstep;
            if (last && has_next) S.a_ready(nxt);
            if constexpr (SP2) {
            PG8_LDB(B0, 0, 0); PG8_LDB(B1, 0, 1); PG8_SCHED; PG8_LDA(At, 0, 0); PG8_STAGE(PG8_SA(1, 1), a1 + hstep, voffA);
            PG8_WAIT_V(8); PG8_WAIT_L(0); PG8_BAR; PG8_MMA(0, 0, At, B0); PG8_MMA(0, 1, At, B1); PG8_BAR; PG8_SCHED;
            PG8_LDA(At, 0, 1); PG8_STAGE(PG8_SB(0, 0), b2, voffB); PG8_STAGE(PG8_SB(0, 1), b2 + hstep, voffB); PG8_STAGE(PG8_SA(0, 0), a2, voffA);
            PG8_WAIT_V(8); PG8_WAIT_L(0); PG8_BAR; PG8_MMA(1, 0, At, B0); PG8_MMA(1, 1, At, B1); PG8_BAR; PG8_SCHED;
            PG8_LDB(B0, 1, 0); PG8_LDB(B1, 1, 1); PG8_SCHED; PG8_LDA(At, 1, 0); PG8_STAGE(PG8_SA(0, 1), a2 + hstep, voffA);
            PG8_WAIT_V(8); PG8_WAIT_L(0); PG8_BAR; PG8_MMA(0, 0, At, B0); PG8_MMA(0, 1, At, B1); PG8_BAR; PG8_SCHED;
            PG8_LDA(At, 1, 1); PG8_STAGE(PG8_SB(1, 0), b3, voffB); PG8_STAGE(PG8_SB(1, 1), b3 + hstep, voffB); PG8_STAGE(PG8_SA(1, 0), a3, voffA);
            PG8_WAIT_V(8); PG8_WAIT_L(0); PG8_BAR; PG8_MMA(1, 0, At, B0); PG8_MMA(1, 1, At, B1); PG8_BAR; PG8_SCHED;
            } else {
            PG8_LDB(B0, 0, 0); PG8_SCHED; PG8_LDA(At, 0, 0); PG8_STAGE(PG8_SA(1, 1), a1 + hstep, voffA);
            PG8_WAIT_L(8); PG8_BAR; PG8_WAIT_L(0); PG8_MMA(0, 0, At, B0); PG8_BAR; PG8_SCHED;
            PG8_LDB(B1, 0, 1); PG8_STAGE(PG8_SB(0, 0), b2, voffB);
            PG8_BAR; PG8_WAIT_L(0); PG8_MMA(0, 1, At, B1); PG8_BAR;
            PG8_LDA(At, 0, 1); PG8_STAGE(PG8_SA(0, 0), a2, voffA);
            PG8_BAR; PG8_WAIT_L(0); PG8_MMA(1, 0, At, B0); PG8_BAR; PG8_SCHED;
            PG8_STAGE(PG8_SB(0, 1), b2 + hstep, voffB);
            PG8_WAIT_V(6); PG8_BAR; PG8_MMA(1, 1, At, B1); PG8_BAR;
            PG8_LDB(B0, 1, 0); PG8_SCHED; PG8_LDA(At, 1, 0); PG8_STAGE(PG8_SA(0, 1), a2 + hstep, voffA);
            PG8_WAIT_L(8); PG8_BAR; PG8_WAIT_L(0); PG8_MMA(0, 0, At, B0); PG8_BAR; PG8_SCHED;
            PG8_LDB(B1, 1, 1); PG8_STAGE(PG8_SB(1, 0), b3, voffB);
            PG8_BAR; PG8_WAIT_L(0); PG8_MMA(0, 1, At, B1); PG8_BAR;
            PG8_LDA(At, 1, 1); PG8_STAGE(PG8_SA(1, 0), a3, voffA);
            PG8_BAR; PG8_WAIT_L(0); PG8_MMA(1, 0, At, B0); PG8_BAR; PG8_SCHED;
            PG8_STAGE(PG8_SB(1, 1), b3 + hstep, voffB);
            PG8_WAIT_V(6); PG8_BAR; PG8_MMA(1, 1, At, B1); PG8_BAR;
            }
        }
        if constexpr (ALIGN_EPI) { if (wr == 0) PG8_BAR; }
        if constexpr (!Epi::AFTER_DRAIN) { E(acc, cur, wr, wc, fr, fq); S.done(cur); }
        if (!has_next) break;
#pragma unroll
        for (int a = 0; a < 2; ++a)
#pragma unroll
            for (int b = 0; b < 2; ++b)
#pragma unroll
                for (int m = 0; m < 4; ++m)
#pragma unroll
                    for (int n = 0; n < 2; ++n) acc[a][b][m][n] = (f32x4){0.f, 0.f, 0.f, 0.f};
        cur = nxt; cA = nA; cB = nB; ++ui;
        if constexpr (ALIGN_EPI) { if (wr == 1) PG8_BAR; }
    }
    PG8_WAIT_V(0);
    if constexpr (!ALIGN_EPI) { if (wr == 0) PG8_BAR; }
    PG8_BAR;
    if constexpr (Epi::AFTER_DRAIN) { E.fused(acc, cur, wr, wc, fr, fq, lds, wid, lane); S.done(cur); }
#undef PG8_SA
#undef PG8_SB
#undef PG8_STAGE
#undef PG8_LDA
#undef PG8_LDB
#undef PG8_MMA
#undef PG8_WAIT_V
#undef PG8_WAIT_L
#undef PG8_BAR
#undef PG8_SCHED
}}

DI void p0_transpose(const Ctx& cx, const float* W, bf16_t* Wt, int K, int N, int tk, int tn, int perm, unsigned char* lds) {
  float* s = (float*)lds;
  const int t = cx.tid;
  __syncthreads();
#pragma unroll
  for (int i = 0; i < 8; ++i) { const int k = i * 8 + (t >> 6), n = t & 63; s[k * 65 + n] = W[(size_t)(tk * 64 + k) * N + tn * 64 + n]; }
  __syncthreads();
#pragma unroll
  for (int i = 0; i < 4; ++i) { const int n = i * 16 + (t >> 5), kk = (t & 31) * 2;
    const int orow = perm ? (256 * (tn >> 2) + 128 * (n >> 5) + 32 * (tn & 3) + (n & 31)) : tn * 64 + n;
    *(unsigned*)(Wt + (size_t)orow * K + tk * 64 + kk) = pk2(s[kk * 65 + n], s[(kk + 1) * 65 + n]); }
}
DI void p0_mod(const Ctx& cx, const Params& p, int item, unsigned char* lds) {
  float* sS = (float*)lds;
  float* red = (float*)(lds + 9 * 1024 * 4);
  const int t = cx.tid, lane = t & 63, w = t >> 6;
  const int l = item / 96, cc = item % 96;
  __syncthreads();
  for (int e = t; e < 9 * 1024; e += NTHR) { const int i = e >> 10, k = e & 1023; const float v = (i < 8) ? p.c[i * 1024 + k] : p.c_ctx[k]; sS[e] = v / (1.f + __expf(-v)); }
  __syncthreads();
  float acc[9];
#pragma unroll
  for (int i = 0; i < 9; ++i) acc[i] = 0.f;
  const float* wp = p.w_mod + (size_t)l * 1024 * 6144 + cc * 64 + lane;
  for (int k = w * 128; k < w * 128 + 128; ++k) { const float wv = wp[(size_t)k * 6144];
#pragma unroll
    for (int i = 0; i < 9; ++i) acc[i] += sS[i * 1024 + k] * wv; }
#pragma unroll
  for (int i = 0; i < 9; ++i) red[(w * 9 + i) * 64 + lane] = acc[i];
  __syncthreads();
  float* mod = (float*)(p.ws + OFF_MOD);
  for (int e = t; e < 576; e += NTHR) { const int i = e >> 6, n = e & 63;
    float v = p.b_mod[l * 6144 + cc * 64 + n];
#pragma unroll
    for (int ww = 0; ww < 8; ++ww) v += red[(ww * 9 + i) * 64 + n];
    mod[(size_t)(l * 9 + i) * 6144 + cc * 64 + n] = v; }
}
DI void phase_prep(const Ctx& cx, const Params& p, unsigned char* lds, int l, int misc) {
  const int N_MISC = misc ? 193 : 0;
  constexpr int TW_IN = 16 * 36, TW_OUT = 16 * 16, TW_1 = 16 * 64, TW_2 = 64 * 16, TW_L = TW_IN + TW_OUT + TW_1 + TW_2;
  const int total = N_MISC + TW_L;
  for (int it = cx.bid; it < total; it += cx.nb) {
    if (it < N_MISC) {
      if (it < 192) p0_mod(cx, p, it, lds);
      else { float* rt = (float*)(p.ws + OFF_ROPE);
        for (int e = cx.tid; e < 1024; e += NTHR) { const int pos = e >> 4, f = e & 15; const float inv = powf(10000.f, -(float)f / 16.f); const float ang = (float)pos * inv;
          rt[e] = cosf(ang); rt[1024 + e] = sinf(ang); } }
    } else {
      int i = it - N_MISC;
      if (i < TW_IN) { p0_transpose(cx, p.w_in + (size_t)l * DM * INW, (bf16_t*)(p.ws + OFF_WIN), DM, INW, i / 36, i % 36, 1, lds); }
      else if (i < TW_IN + TW_OUT) { i -= TW_IN; p0_transpose(cx, p.w_out + (size_t)l * DM * DM, (bf16_t*)(p.ws + OFF_WOUT), DM, DM, i / 16, i % 16, 0, lds); }
      else if (i < TW_IN + TW_OUT + TW_1) { i -= TW_IN + TW_OUT; p0_transpose(cx, p.w_mlp_in + (size_t)l * DM * FF, (bf16_t*)(p.ws + OFF_W1), DM, FF, i / 64, i % 64, 0, lds); }
      else { i -= TW_IN + TW_OUT + TW_1; p0_transpose(cx, p.w_mlp_out + (size_t)l * FF * DM, (bf16_t*)(p.ws + OFF_W2), FF, DM, i / 16, i % 16, 0, lds); }
    }
  }
}

DI float wave_sum(float v) {
#pragma unroll
  for (int o = 32; o >= 1; o >>= 1) v += __shfl_xor(v, o);
  return v;
}
DI void phase_rowpass(const Ctx& cx, const Params& p, int mode, int layer) {
  const int lane = cx.tid & 63, w = cx.tid >> 6;
  const bool latent_only = (layer == 1 && mode != 0);
  const int nrows = latent_only ? NB * T : R;
  float* X = (float*)(p.ws + OFF_X);
  bf16_t* HA = (bf16_t*)(p.ws + OFF_A);
  const bf16_t* MF = (const bf16_t*)(p.ws + OFF_B);
  const float* mod = (const float*)(p.ws + OFF_MOD);
  for (int it = cx.bid * NWV + w; it < nrows; it += cx.nb * NWV) {
    const int row = latent_only ? ((it >> 11) * P + LC + (it & 2047)) : it;
    const int b = row / P, pp = row - b * P, mi = (pp < LC) ? 8 : b;
    const float* modp = mod + (size_t)(layer * 9 + mi) * 6144;
    const float* resid;
    if (mode == 0 || (mode == 1 && layer == 0)) resid = (pp < LC) ? p.ctx + ((size_t)b * LC + pp) * DM : p.x + ((size_t)b * T + pp - LC) * DM;
    else resid = X + (size_t)row * DM;
    f32x4 xv[4];
#pragma unroll
    for (int i = 0; i < 4; ++i) xv[i] = *(const f32x4*)(resid + lane * 4 + 256 * i);
    if (mode != 0) {
      const bf16_t* src = (mode == 1 ? MF : HA) + (size_t)row * DM;
      const float* gate = modp + (mode == 1 ? 2048 : 5120);
      const float* na = p.norm_g + (size_t)(layer * 4 + (mode == 1 ? 1 : 3)) * DM;
      f32x4 mv[4]; float ss = 0.f;
#pragma unroll
      for (int i = 0; i < 4; ++i) { const u32x2 u = *(const u32x2*)(src + lane * 4 + 256 * i); mv[i] = (f32x4){bflo(u.x), bfhi(u.x), bflo(u.y), bfhi(u.y)};
        ss += mv[i][0] * mv[i][0] + mv[i][1] * mv[i][1] + mv[i][2] * mv[i][2] + mv[i][3] * mv[i][3]; }
      ss = wave_sum(ss);
      const float rstd = rsqrtf(ss * (1.f / DM) + EPS);
#pragma unroll
      for (int i = 0; i < 4; ++i) { const f32x4 g = *(const f32x4*)(gate + lane * 4 + 256 * i), n = *(const f32x4*)(na + lane * 4 + 256 * i);
        xv[i] = xv[i] + g * (mv[i] * rstd * n); }
      float* dst = (mode == 2 && layer == 1) ? p.out + ((size_t)b * T + pp - LC) * DM : X + (size_t)row * DM;
#pragma unroll
      for (int i = 0; i < 4; ++i) *(f32x4*)(dst + lane * 4 + 256 * i) = xv[i];
    }
    if (!(mode == 2 && layer == 1)) {
      const float* nb; const float* sh; const float* sc;
      if (mode == 0) { nb = p.norm_g + (size_t)(layer * 4 + 0) * DM; sh = modp; sc = modp + 1024; }
      else if (mode == 1) { nb = p.norm_g + (size_t)(layer * 4 + 2) * DM; sh = modp + 3072; sc = modp + 4096; }
      else { const float* modn = mod + (size_t)((layer + 1) * 9 + mi) * 6144; nb = p.norm_g + (size_t)((layer + 1) * 4 + 0) * DM; sh = modn; sc = modn + 1024; }
      float ss = 0.f;
#pragma unroll
      for (int i = 0; i < 4; ++i) ss += xv[i][0] * xv[i][0] + xv[i][1] * xv[i][1] + xv[i][2] * xv[i][2] + xv[i][3] * xv[i][3];
      ss = wave_sum(ss);
      const float rstd = rsqrtf(ss * (1.f / DM) + EPS);
      bf16_t* hd = HA + (size_t)row * DM;
#pragma unroll
      for (int i = 0; i < 4; ++i) { const f32x4 n = *(const f32x4*)(nb + lane * 4 + 256 * i), s1 = *(const f32x4*)(sc + lane * 4 + 256 * i), s0 = *(const f32x4*)(sh + lane * 4 + 256 * i);
        const f32x4 hv = (xv[i] * rstd * n) * (1.f + s1) + s0;
        *(u32x2*)(hd + lane * 4 + 256 * i) = (u32x2){pk2(hv[0], hv[1]), pk2(hv[2], hv[3])}; }
    }
  }
}

constexpr int VS_OFF = 16384, RPB_OFF = 16384 + 128 * 136;
template <int MODE>
DI void attn_item(const Ctx& cx, const Params& p, unsigned char* lds, int b, int h, int q0, int n0, int t1s, int t1e) {
  constexpr int NDB = (MODE == 1) ? 4 : 2;
  constexpr int NK = (MODE == 1) ? 2 : 1;
  constexpr int NVC = NDB / 2;
  const int t = cx.tid, lane = t & 63, w = t >> 6, r32 = lane & 31, hh = lane >> 5;
  const bf16_t* Qb = (const bf16_t*)(p.ws + OFF_Q); const bf16_t* Kb = (const bf16_t*)(p.ws + OFF_K); const bf16_t* Vt = (const bf16_t*)(p.ws + OFF_VT);
  bf16_t* Ob = (bf16_t*)(p.ws + OFF_A);
  int cq, ck, cv, kidx, qoff, ocol;
  if (MODE == 0 || MODE == 2) { cq = h; ck = h >> 2; cv = h >> 2; kidx = 0; qoff = 32 * w; ocol = h * 64; }
  else if (MODE == 3) { cq = 8 + h; ck = 2 + h; cv = 2 + h; kidx = 0; qoff = 32 * w; ocol = 512 + h * 64; }
  else { const int j = w >> 2; cq = 8 + 2 * h + j; ck = 2 + 2 * h; cv = 2 + 2 * h; kidx = j; qoff = 32 * (w & 3); ocol = 512 + h * 128; }
  const size_t rowbase = (size_t)b * P;
  const int qp = q0 + qoff + r32;
  bf16x8 qf[4];
  { const bf16_t* qptr = Qb + (rowbase + qp) * 1024 + cq * 64 + hh * 8;
#pragma unroll
    for (int ks = 0; ks < 4; ++ks) qf[ks] = *(const bf16x8*)(qptr + ks * 16); }
  float m_run = -1e30f, l_run = 0.f;
  if (MODE == 2) { m_run = p.sink_c[h] * LOG2E; l_run = 1.f; }
  f32x16 O[NDB];
#pragma unroll
  for (int db = 0; db < NDB; ++db)
#pragma unroll
    for (int i = 0; i < 16; ++i) O[db][i] = 0.f;
  __syncthreads();
  const float* rpbs = (const float*)(lds + RPB_OFF);
  if (MODE == 3) { float* rp = (float*)(lds + RPB_OFF); for (int i = t; i < 465; i += NTHR) rp[i] = p.rpb_d[h * 465 + i] * LOG2E; }
  const int srow = t >> 3, skc = t & 7;
  const unsigned ksw = (unsigned)(srow * 128 + ((skc ^ ((srow >> 1) & 7)) << 4));
  const int ksx = (r32 >> 1) & 7;
  u32x4 kreg[NK], vreg[NVC];
  const int ntl = n0 + (t1e - t1s);
  auto tile_of = [&](int i) { return i < n0 ? i : t1s + (i - n0); };
  auto prefetch = [&](int tile) {
    const size_t key0 = rowbase + (size_t)tile * 64;
#pragma unroll
    for (int kk = 0; kk < NK; ++kk) kreg[kk] = *(const u32x4*)(Kb + (key0 + srow) * 640 + (ck + kk) * 64 + skc * 8);
#pragma unroll
    for (int i = 0; i < NVC; ++i) vreg[i] = *(const u32x4*)(Vt + ((size_t)(b * 10 + cv) * 64 + srow + 64 * i) * P + tile * 64 + skc * 8);
  };
  auto stage = [&]() {
#pragma unroll
    for (int kk = 0; kk < NK; ++kk) *(u32x4*)(lds + kk * 8192 + ksw) = kreg[kk];
#pragma unroll
    for (int i = 0; i < NVC; ++i) { unsigned char* d = lds + VS_OFF + (srow + 64 * i) * 136 + skc * 16;
      *(u32x2*)d = (u32x2){vreg[i].x, vreg[i].y}; *(u32x2*)(d + 8) = (u32x2){vreg[i].z, vreg[i].w}; }
  };
  const int qpos = qp - LC;
  const int qw0 = q0 - LC + qoff;
  const int qr = qpos >> 6, qc = qpos & 63;
  auto compute = [&](int tile) {
    int krow_ = 0;
    if (MODE == 3 && tile >= 4) { krow_ = tile - 4; const int rs = clampi((qw0 >> 6) - 4, 0, 24); if (krow_ < rs || krow_ >= rs + 8) return; }
    if (MODE == 2 && tile >= 4) { const int k0 = (tile - 4) * 64; if (k0 > qw0 + 31 + 128 || k0 + 63 < qw0 - 128) return; }
#pragma unroll 1
    for (int kt = 0; kt < 2; ++kt) {
      f32x16 S;
#pragma unroll
      for (int i = 0; i < 16; ++i) S[i] = 0.f;
#pragma unroll
      for (int ks = 0; ks < 4; ++ks) {
        const bf16x8 a = *(const bf16x8*)(lds + kidx * 8192 + (kt * 32 + r32) * 128 + (((2 * ks + hh) ^ ksx) << 4));
        S = __builtin_amdgcn_mfma_f32_32x32x16_bf16(a, qf[ks], S, 0, 0, 0);
      }
      if (MODE == 2 && tile >= 4) {
#pragma unroll
        for (int i = 0; i < 16; ++i) { const int d = (tile - 4) * 64 + kt * 32 + crow(i, hh) - qpos; if (d > 128 || d < -128) S[i] = -1e30f; }
      }
      if (MODE == 3 && tile >= 4) {
        const int cs = clampi(qc - 8, 0, 48);
        const float* rp = rpbs + (krow_ - qr + 7) * 31 + 15;
#pragma unroll
        for (int i = 0; i < 16; ++i) { const int kc = kt * 32 + crow(i, hh); const bool valid = (kc >= cs) && (kc < cs + 16); const int dc = clampi(kc - qc, -15, 15);
          S[i] = valid ? S[i] + rp[dc] : -1e30f; }
      }
      float mx = S[0];
#pragma unroll
      for (int i = 1; i < 16; ++i) mx = fmaxf(mx, S[i]);
      mx = fmaxf(mx, __shfl_xor(mx, 32));
      const float m_new = fmaxf(m_run, mx);
      const bool grew = m_new > m_run;
      const float alpha = __builtin_amdgcn_exp2f(m_run - m_new);
      float ps = 0.f;
#pragma unroll
      for (int i = 0; i < 16; ++i) { const float pv = __builtin_amdgcn_exp2f(S[i] - m_new); S[i] = pv; ps += pv; }
      ps += __shfl_xor(ps, 32);
      l_run = l_run * alpha + ps; m_run = m_new;
      if (__builtin_amdgcn_ballot_w64(grew) != 0ull) {
#pragma unroll
        for (int db = 0; db < NDB; ++db)
#pragma unroll
          for (int i = 0; i < 16; ++i) O[db][i] *= alpha;
      }
      bf16x8 pf[2];
#pragma unroll
      for (int s = 0; s < 2; ++s) {
        u32x4 u; u.x = pk2(S[8 * s + 0], S[8 * s + 1]); u.y = pk2(S[8 * s + 2], S[8 * s + 3]); u.z = pk2(S[8 * s + 4], S[8 * s + 5]); u.w = pk2(S[8 * s + 6], S[8 * s + 7]);
        pf[s] = __builtin_bit_cast(bf16x8, u);
      }
#pragma unroll
      for (int db = 0; db < NDB; ++db)
#pragma unroll
        for (int s = 0; s < 2; ++s) {
          const unsigned char* vb = lds + VS_OFF + (db * 32 + r32) * 136 + (kt * 32 + 16 * s + 4 * hh) * 2;
          const s16x4 lo = *(const s16x4*)vb, hi = *(const s16x4*)(vb + 16);
          const bf16x8 a = __builtin_shufflevector(lo, hi, 0, 1, 2, 3, 4, 5, 6, 7);
          O[db] = __builtin_amdgcn_mfma_f32_32x32x16_bf16(a, pf[s], O[db], 0, 0, 0);
        }
    }
  };
  prefetch(tile_of(0));
  for (int i = 0; i < ntl; ++i) {
    __syncthreads();
    stage();
    __syncthreads();
    if (i + 1 < ntl) prefetch(tile_of(i + 1));
    __builtin_amdgcn_sched_barrier(0);
    compute(tile_of(i));
  }
  const float inv = 1.f / l_run;
  bf16_t* orow = Ob + (rowbase + qp) * 1024 + ocol;
  if (MODE != 1) {
#pragma unroll
    for (int db = 0; db < NDB; ++db)
#pragma unroll
      for (int g = 0; g < 4; ++g) {
        const int dv = db * 32 + 8 * g + 4 * hh;
        *(u32x2*)(orow + dv) = (u32x2){pk2(O[db][4 * g] * inv, O[db][4 * g + 1] * inv), pk2(O[db][4 * g + 2] * inv, O[db][4 * g + 3] * inv)};
      }
  } else {
    const float* lp = p.diff_lambda;
    float s1 = lp[lane] * lp[64 + lane], s2 = lp[128 + lane] * lp[192 + lane];
    s1 = wave_sum(s1); s2 = wave_sum(s2);
    const float lam = __expf(s1) - __expf(s2) + 0.2f;
    float* xch = (float*)lds;
    __syncthreads();
    if (w >= 4) {
#pragma unroll
      for (int db = 0; db < NDB; ++db)
#pragma unroll
        for (int i = 0; i < 16; ++i) xch[(db * 32 + crow(i, hh)) * 128 + qoff + r32] = O[db][i] * inv;
    }
    __syncthreads();
    if (w < 4) {
      float ss = 0.f;
#pragma unroll
      for (int db = 0; db < NDB; ++db)
#pragma unroll
        for (int i = 0; i < 16; ++i) { const float o = O[db][i] * inv - lam * xch[(db * 32 + crow(i, hh)) * 128 + qoff + r32]; O[db][i] = o; ss += o * o; }
      ss += __shfl_xor(ss, 32);
      const float rstd = rsqrtf(ss * (1.f / 128.f) + EPS) * 0.8f;
#pragma unroll
      for (int db = 0; db < NDB; ++db)
#pragma unroll
        for (int g = 0; g < 4; ++g) {
          const int dv = db * 32 + 8 * g + 4 * hh;
          const f32x4 sg = *(const f32x4*)(p.diff_subln + dv);
          *(u32x2*)(orow + dv) = (u32x2){pk2(O[db][4 * g] * rstd * sg[0], O[db][4 * g + 1] * rstd * sg[1]), pk2(O[db][4 * g + 2] * rstd * sg[2], O[db][4 * g + 3] * rstd * sg[3])};
        }
    }
  }
}
DI void phase_attn(const Ctx& cx, const Params& p, int layer, unsigned char* lds) {
  const int total = (layer == 0) ? 1152 : 1024;
  for (int idx = cx.bid; idx < total; idx += cx.nb) {
    int mode, b, h, q0, n0 = 4, t1s = 0, t1e = 0;
    if (layer == 0) {
      if (idx < 512) { mode = 0; const int qb = idx & 7; h = (idx >> 3) & 7; b = idx >> 6; q0 = LC + qb * 256; n0 = 36; }
      else if (idx < 1024) { const int i = idx - 512; mode = 1; const int qb = i & 15; h = (i >> 4) & 3; b = i >> 6; q0 = LC + qb * 128; n0 = 36; }
      else if (idx < 1088) { const int i = idx - 1024; mode = 0; h = i & 7; b = i >> 3; q0 = 0; }
      else { const int i = idx - 1088; mode = 1; const int qb = i & 1; h = (i >> 1) & 3; b = i >> 3; q0 = qb * 128; }
    } else {
      const int i = idx & 511; const int qb = i & 7; h = (i >> 3) & 7; b = i >> 6; q0 = LC + qb * 256;
      if (idx < 512) { mode = 3; t1s = 4 + clampi(4 * qb - 4, 0, 24); t1e = 4 + clampi(4 * qb - 1, 0, 24) + 8; }
      else { mode = 2; t1s = 4 + (4 * qb - 2 > 0 ? 4 * qb - 2 : 0); t1e = 4 + (4 * qb + 6 < 32 ? 4 * qb + 6 : 32); }
    }
    if (mode == 0) attn_item<0>(cx, p, lds, b, h, q0, n0, t1s, t1e);
    else if (mode == 1) attn_item<1>(cx, p, lds, b, h, q0, n0, t1s, t1e);
    else if (mode == 2) attn_item<2>(cx, p, lds, b, h, q0, n0, t1s, t1e);
    else attn_item<3>(cx, p, lds, b, h, q0, n0, t1s, t1e);
  }
}

constexpr int NPH = 18;
DI void run_phase(const Ctx& cx, const Params& p, int ph, unsigned char* lds) {
  bf16_t* WIN = (bf16_t*)(p.ws + OFF_WIN); bf16_t* WOUT = (bf16_t*)(p.ws + OFF_WOUT); bf16_t* W1 = (bf16_t*)(p.ws + OFF_W1); bf16_t* W2 = (bf16_t*)(p.ws + OFF_W2);
  bf16_t* RA = (bf16_t*)(p.ws + OFF_A); bf16_t* RB = (bf16_t*)(p.ws + OFF_B); bf16_t* U = (bf16_t*)(p.ws + OFF_U);
  PG8_LAS unsigned char* l3 = (PG8_LAS unsigned char*)lds;
  if (ph == 0) { phase_prep(cx, p, lds, 0, 1); return; }
  if (ph == 1) { phase_rowpass(cx, p, 0, 0); return; }
  const int layer = ph >= 11 ? 1 : 0;
  const int lp = ph - (layer ? 11 : 2);
  pg8::StaticOrder S;
  if (lp == 0) {
    pg8::Gemm g{RA, WIN, R, INW, DM}; S.init(72, 9, cx.nb, cx.bid, 0, 0, 0);
    pg8::EpiInproj E{p.qk_norm_a, (const float*)(p.ws + OFF_ROPE), (bf16_t*)(p.ws + OFF_Q), (bf16_t*)(p.ws + OFF_K), (bf16_t*)(p.ws + OFF_VT), layer};
    pg8::gemm_phase<pg8::EpiInproj, pg8::StaticOrder, true, true>(l3, g, S, E, cx.tid); return;
  }
  if (lp == 1) { phase_attn(cx, p, layer, lds); return; }
  if (lp == 2) {
    pg8::Gemm g{RA, WOUT, R, DM, DM}; S.init(layer ? 64 : 72, 4, cx.nb, cx.bid, layer ? 1 : 0, 0, 0);
    pg8::EpiBf16<0> E{RB, DM};
    pg8::gemm_phase<pg8::EpiBf16<0>, pg8::StaticOrder, true, true>(l3, g, S, E, cx.tid); return;
  }
  if (lp == 3) { phase_rowpass(cx, p, 1, layer); return; }
  const int nmlp = layer ? 2 : 4;
  if (lp < 4 + nmlp) {
    const int pass = (lp - 4) >> 1, isdown = (lp - 4) & 1;
    const int nmt = pass ? 8 : 64, map = pass ? 2 : 1;
    if (!isdown) { pg8::Gemm g{RA, W1, R, FF, DM}; S.init(nmt, 16, cx.nb, cx.bid, map, 0, 1); pg8::EpiBf16<2> E{U, FF};
      pg8::gemm_phase<pg8::EpiBf16<2>, pg8::StaticOrder, true, true>(l3, g, S, E, cx.tid); }
    else { pg8::Gemm g{U, W2, R, DM, FF}; S.init(nmt, 4, cx.nb, cx.bid, map, 1, 0); pg8::EpiBf16<0> E{RA, DM};
      pg8::gemm_phase<pg8::EpiBf16<0>, pg8::StaticOrder, true, true>(l3, g, S, E, cx.tid); }
    return;
  }
  phase_rowpass(cx, p, 2, layer);
  if (layer == 0) phase_prep(cx, p, lds, 1, 0);
}

#if !MULTI
__global__ void __launch_bounds__(NTHR, 2) fwd_megakernel(Params p) {
  extern __shared__ __attribute__((aligned(16))) unsigned char smem[];
  cg::grid_group grid = cg::this_grid();
  XcdBarrier xb; xb.bar = (unsigned*)(p.ws + OFF_BAR); xb.x = xb_xcc_id(); xb.nloc = 0u; xb.nx = 0u;
  if (threadIdx.x == 0) (void)xb_add(&xb.bar[XB_XCNT(xb.x)], 1u);
  for (int ph = 0; ph < NPH; ++ph) {
    Ctx cx; cx.tid = threadIdx.x; cx.bid = blockIdx.x; cx.nb = gridDim.x;
    asm volatile("" : "+v"(cx.tid)); asm volatile("" : "+s"(cx.bid));
    run_phase(cx, p, ph, smem);
    if (ph == 0) grid.sync();
    else if (ph + 1 < NPH) xcd_barrier(xb);
  }
}
#else
__global__ void __launch_bounds__(NTHR, 2) phase_kernel(Params p, int ph) {
  extern __shared__ __attribute__((aligned(16))) unsigned char smem[];
  Ctx cx; cx.tid = threadIdx.x; cx.bid = blockIdx.x; cx.nb = gridDim.x;
  run_phase(cx, p, ph, smem);
}
#endif
#if MULTI
#define MAINK phase_kernel
#else
#define MAINK fwd_megakernel
#endif

extern "C" void kernel_launch(void* const* d_in, const int* in_sizes, int n_in, void* d_out, int out_size, void* d_ws, size_t ws_size, hipStream_t stream) {
  Params p{};
  p.x = (const float*)d_in[0]; p.c = (const float*)d_in[1]; p.ctx = (const float*)d_in[2]; p.c_ctx = (const float*)d_in[3];
  p.w_mod = (const float*)d_in[4]; p.b_mod = (const float*)d_in[5]; p.norm_g = (const float*)d_in[6]; p.w_in = (const float*)d_in[7];
  p.w_out = (const float*)d_in[8]; p.w_mlp_in = (const float*)d_in[9]; p.w_mlp_out = (const float*)d_in[10]; p.qk_norm_a = (const float*)d_in[11];
  p.diff_lambda = (const float*)d_in[12]; p.diff_subln = (const float*)d_in[13]; p.sink_c = (const float*)d_in[14]; p.rpb_d = (const float*)d_in[15];
  p.out = (float*)d_out; p.ws = (unsigned char*)d_ws;
  if (ws_size < WS_END) { fprintf(stderr, "workspace too small: %zu < %zu\n", ws_size, (size_t)WS_END); return; }
  static int grid_blocks = 0;
  if (!grid_blocks) {
    int dev = 0, cus = 0, per_cu = 0;
    hipGetDevice(&dev);
    hipDeviceGetAttribute(&cus, hipDeviceAttributeMultiprocessorCount, dev);
    hipFuncSetAttribute((const void*)MAINK, hipFuncAttributeMaxDynamicSharedMemorySize, LDS_BYTES);
    hipOccupancyMaxActiveBlocksPerMultiprocessor(&per_cu, MAINK, NTHR, LDS_BYTES);
    if (per_cu != 1) fprintf(stderr, "note: occupancy query says %d blocks/CU; launching one per CU\n", per_cu);
    (void)hipGetLastError();
    grid_blocks = cus;
  }
#if MULTI
  for (int ph = 0; ph < NPH; ++ph) phase_kernel<<<dim3(grid_blocks), dim3(NTHR), LDS_BYTES, stream>>>(p, ph);
#else
  hipMemsetAsync(d_ws, 0, 16384, stream);
  void* args[] = {&p};
  hipError_t e = hipLaunchCooperativeKernel((void*)fwd_megakernel, dim3(grid_blocks), dim3(NTHR), args, LDS_BYTES, stream);
  if (e != hipSuccess) fprintf(stderr, "cooperative launch failed: %s (grid %d)\n", hipGetErrorString(e), grid_blocks);
#endif
}
```

```cpp
#include <hip/hip_runtime.h>
#include <hip/hip_cooperative_groups.h>
#include <cstdint>
#include <cstdio>
namespace cg = cooperative_groups;

#ifndef MULTI
#define MULTI 0
#endif

#define DI __device__ __forceinline__
typedef unsigned short bf16_t;
typedef short bf16x8 __attribute__((ext_vector_type(8)));
typedef short s16x4 __attribute__((ext_vector_type(4)));
typedef float f32x2 __attribute__((ext_vector_type(2)));
typedef float f32x4 __attribute__((ext_vector_type(4)));
typedef float f32x16 __attribute__((ext_vector_type(16)));
typedef unsigned u32x2 __attribute__((ext_vector_type(2)));
typedef unsigned u32x4 __attribute__((ext_vector_type(4)));
typedef __bf16 bf16x2_t __attribute__((ext_vector_type(2)));

constexpr int NB = 8, T = 2048, LC = 256, P = 2304, R = NB * P, DM = 1024, INW = 2304, FF = 4096;
constexpr int NTHR = 512, NWV = 8;
constexpr int LDS_BYTES = 131072;
constexpr float EPS = 1e-6f;
constexpr float LOG2E = 1.4426950408889634f;

constexpr size_t OFF_BAR = 0;
constexpr size_t OFF_MOD = 16384;
constexpr size_t OFF_ROPE = OFF_MOD + 2 * 9 * 6144 * 4;
constexpr size_t OFF_W1 = 524288;
constexpr size_t OFF_W2 = OFF_W1 + (size_t)FF * DM * 2;
constexpr size_t OFF_X = OFF_W2 + (size_t)FF * DM * 2;
constexpr size_t OFF_A = OFF_X + (size_t)R * DM * 4;
constexpr size_t OFF_WIN = OFF_A + (size_t)R * DM * 2;
constexpr size_t OFF_WOUT = OFF_WIN + (size_t)INW * DM * 2;
constexpr size_t OFF_B = OFF_WOUT + (size_t)DM * DM * 2;
constexpr size_t OFF_Q = OFF_B;
constexpr size_t OFF_K = OFF_Q + (size_t)R * DM * 2;
constexpr size_t OFF_VT = OFF_K + (size_t)R * 640 * 2;
constexpr size_t OFF_U = OFF_WIN;
constexpr size_t OFF_SLAB = OFF_U + (size_t)NB * LC * FF * 2;
constexpr size_t WS_END = OFF_U + (size_t)16384 * FF * 2;
static_assert(OFF_SLAB + (size_t)8 * NB * LC * DM * 2 <= WS_END, "slabs");
static_assert(OFF_VT + (size_t)R * 640 * 2 <= WS_END && WS_END <= 268435456ull, "workspace map");

struct Params {
  const float *x, *c, *ctx, *c_ctx, *w_mod, *b_mod, *norm_g, *w_in, *w_out, *w_mlp_in, *w_mlp_out, *qk_norm_a, *diff_lambda, *diff_subln, *sink_c, *rpb_d;
  float* out;
  unsigned char* ws;
};

struct Ctx { int tid, bid, nb; };
DI unsigned pk2(float lo, float hi) { f32x2 v = {lo, hi}; return __builtin_bit_cast(unsigned, __builtin_convertvector(v, bf16x2_t)); }
DI float bflo(unsigned u) { return __uint_as_float(u << 16); }
DI float bfhi(unsigned u) { return __uint_as_float(u & 0xffff0000u); }
DI int clampi(int v, int lo, int hi) { return v < lo ? lo : (v > hi ? hi : v); }
DI int crow(int i, int hh) { return (i & 3) + 8 * (i >> 2) + 4 * hh; }

#define XB_TMO      128
#define XB_XCNT(j)  (256  + 64 * (j))
#define XB_XSUB(j)  (1280 + 64 * (j))
#define XB_XGEN(j)  (2304 + 64 * (j))
#define XB_TOP      3328
#define XB_TOPGEN   3392
#define XCD_BAR_WORDS 3456
#define XB_SPIN_CAP (1u << 20)
DI unsigned xb_ld(unsigned* p) { return __hip_atomic_load(p, __ATOMIC_RELAXED, __HIP_MEMORY_SCOPE_AGENT); }
DI unsigned xb_add(unsigned* p, unsigned v) { return __hip_atomic_fetch_add(p, v, __ATOMIC_RELAXED, __HIP_MEMORY_SCOPE_AGENT); }
DI unsigned xb_xcc_id() { return (unsigned)__builtin_amdgcn_s_getreg((3 << 11) | 20) & 0xFu; }
#define XB_SPIN(cond, bar) do { unsigned _sp = 0; while (cond) { __builtin_amdgcn_s_sleep(1); \
    if ((++_sp & 255u) == 0u) { if (xb_ld(&(bar)[XB_TMO])) break; if (_sp > XB_SPIN_CAP) { atomicAdd(&(bar)[XB_TMO], 1u); break; } } } } while (0)
struct XcdBarrier { unsigned* bar; unsigned x; unsigned nloc, nx; };
DI void xcd_barrier_complete(unsigned* bar, unsigned x, unsigned& nloc, unsigned& nx) {
  const unsigned G = gridDim.x * gridDim.y * gridDim.z;
  unsigned sum, cnt, mine, sp = 0u;
  for (;;) {
    sum = 0u; cnt = 0u; mine = 0u;
#pragma unroll
    for (unsigned j = 0; j < 16; ++j) { const unsigned c = xb_ld(&bar[XB_XCNT(j)]); sum += c; cnt += (c > 0u) ? 1u : 0u; mine = (j == x) ? c : mine; }
    if (sum == G) break;
    __builtin_amdgcn_s_sleep(1);
    if ((++sp & 255u) == 0u) { if (xb_ld(&bar[XB_TMO])) break; if (sp > XB_SPIN_CAP) { atomicAdd(&bar[XB_TMO], 1u); break; } }
  }
  nloc = mine > 0u ? mine : 1u; nx = cnt > 0u ? cnt : 1u;
}
DI void xcd_barrier(XcdBarrier& b) {
  asm volatile("s_waitcnt vmcnt(0)" ::: "memory");
  __syncthreads();
  if (threadIdx.x == 0) {
    unsigned* bar = b.bar;
    __builtin_amdgcn_s_waitcnt(0);
    if (b.nloc == 0u) xcd_barrier_complete(bar, b.x, b.nloc, b.nx);
    const unsigned nloc = b.nloc, nx = b.nx;
    const unsigned old = xb_add(&bar[XB_XSUB(b.x)], 1u);
    const unsigned gen = old / nloc;
    if (old + 1u == (gen + 1u) * nloc) {
      __builtin_amdgcn_fence(__ATOMIC_RELEASE, "agent");
      asm volatile("s_waitcnt vmcnt(0)" ::: "memory");
      const unsigned og = xb_add(&bar[XB_TOP], 1u);
      const unsigned tg = og / nx;
      if (og + 1u == (tg + 1u) * nx) xb_add(&bar[XB_TOPGEN], 1u);
      else XB_SPIN(xb_ld(&bar[XB_TOPGEN]) == tg, bar);
      __builtin_amdgcn_fence(__ATOMIC_ACQUIRE, "agent");
      xb_add(&bar[XB_XGEN(b.x)], 1u);
      asm volatile("s_waitcnt vmcnt(0)" ::: "memory");
    } else {
      XB_SPIN(xb_ld(&bar[XB_XGEN(b.x)]) == gen, bar);
      __builtin_amdgcn_fence(__ATOMIC_ACQUIRE, "agent");
      asm volatile("s_waitcnt vmcnt(0)" ::: "memory");
    }
  }
  __syncthreads();
}

namespace pg8 {
#define PG8_LAS __attribute__((address_space(3)))
constexpr int BM = 256, BK = 64, HALF = 128, HTB = HALF * BK * 2  , STAGE_BYTES = 8 * HTB, NXCD = 8, WGM = 8;
__host__ __device__ __forceinline__ int lds_byte(int r, int c) { const int st = (r >> 4) * 2 + (c >> 5), rr = r & 15, cc = c & 31, ob = rr * 64 + cc * 2; return st * 1024 + (ob ^ (((ob >> 9) & 1) << 5)); }
__host__ __device__ __forceinline__ void stage_rc(int b, int& R, int& C) { const int st = b / 1024, sb = b % 1024, swz = sb ^ (((sb >> 9) & 1) << 5); R = (st >> 1) * 16 + swz / 64; C = (st & 1) * 32 + (swz % 64) / 2; }
__host__ __device__ __forceinline__ int perm32(int rho) { const int n = rho >> 4, i = rho & 15; return 8 * (i >> 2) + 4 * n + (i & 3); }

struct Unit { int pm, pn, pa, ks; };
struct Gemm { const bf16_t* A; const bf16_t* Bt; int M, N, K, kLen; };

struct StaticOrder {
    int nM, nN, nwg, G, c, map, a_local, c_local, nNr;
    __device__ void init(int nMt, int nNt, int G_, int c_, int map_, int a_local_, int c_local_, int nsplit = 1) { nM = nMt; nNr = nNt; nN = nNt * nsplit; nwg = nM * nN; G = G_; c = c_; map = map_; a_local = a_local_; c_local = c_local_; }
    __device__ bool next(int i, Unit& u) const {
        const long L = (long)i * G + c; if (L >= nwg) return false;
        int wgid = (int)L; { const int q = nwg / NXCD, r = nwg % NXCD, xcd = wgid % NXCD, off = wgid / NXCD; wgid = (xcd < r ? xcd * (q + 1) : r * (q + 1) + (xcd - r) * q) + off; }
        const int nig = WGM * nN, gid = wgid / nig, fm = gid * WGM, gsz = (nM - fm) < WGM ? (nM - fm) : WGM;
        const int mi = fm + ((wgid % nig) % gsz); const int pne = (wgid % nig) / gsz; u.ks = pne / nNr; u.pn = pne - u.ks * nNr;
        const int gt = map == 0 ? mi : (map == 1 ? ((mi >> 3) * 9 + 1 + (mi & 7)) : mi * 9);
        u.pa = a_local ? mi : gt; u.pm = c_local ? mi : gt; return true;
    }
    __device__ __forceinline__ void a_ready(const Unit&) const {}
    __device__ __forceinline__ void done(const Unit&) const {}
};

template <int ACT  > struct EpiBf16 {
    static constexpr bool PERM = true, AFTER_DRAIN = false;
    bf16_t* O; int ldc; size_t slab;
    __device__ __forceinline__ void operator()(const f32x4 (&acc)[2][2][4][2], const Unit& u, int wr, int wc, int fr, int fq) const {
        const int row0 = u.pm * BM + wr * 64 + fr; const int col0 = u.pn * BM + wc * 32 + 8 * fq;
        bf16_t* Ob = O + (size_t)u.ks * slab;
#pragma unroll
        for (int ai = 0; ai < 2; ++ai)
#pragma unroll
            for (int m = 0; m < 4; ++m) { bf16_t* rowp = Ob + (size_t)(row0 + ai * HALF + m * 16) * ldc + col0;
#pragma unroll
                for (int bj = 0; bj < 2; ++bj) { f32x4 v0 = acc[ai][bj][m][0], v1 = acc[ai][bj][m][1];
                    if (ACT == 2) {
#pragma unroll
                        for (int j = 0; j < 4; ++j) { const float a = v0[j] > 0.f ? v0[j] : 0.f, b = v1[j] > 0.f ? v1[j] : 0.f; v0[j] = a * a; v1[j] = b * b; } }
                    u32x4 w; w.x = pk2(v0[0], v0[1]); w.y = pk2(v0[2], v0[3]); w.z = pk2(v1[0], v1[1]); w.w = pk2(v1[2], v1[3]);
                    *(u32x4*)(rowp + bj * HALF) = w; } }
    }
};
struct EpiInproj {
    static constexpr bool PERM = false, AFTER_DRAIN = false;
    const float* qk_g; const float* rt; bf16_t* Qb; bf16_t* Kb; bf16_t* Vt; int layer;
    __device__ __forceinline__ void operator()(const f32x4 (&acc)[2][2][4][2], const Unit& u, int wr, int wc, int fr, int fq) const {
        asm volatile("" : "+v"(fr), "+v"(fq));
        const int hc = 4 * u.pn + wc;
        const bool even = (layer == 0);
        int kind, cidx;
        if (hc < 8) { kind = 0; cidx = hc; } else if (hc < 10) { kind = 1; cidx = hc - 8; } else if (hc < 12) { kind = 2; cidx = hc - 10; }
        else if (hc < 20) { kind = 0; cidx = hc - 12 + 8; } else if (hc < 28) { kind = 1; cidx = hc - 20 + 2; } else { kind = 2; cidx = hc - 28 + 2; }
        const bool do_norm = even && hc < 10;
        const bool do_rope = (hc < 10) || (even && hc >= 12 && hc < 28);
        const float qscale = (kind == 0) ? 0.125f * LOG2E : 1.f;
        const float* g = qk_g + (hc < 8 ? 0 : 64);
        const int grow0 = u.pm * BM;
        const int b = grow0 / P, p0 = grow0 - b * P;
        const bool latent = p0 >= LC;
#pragma unroll
        for (int ai = 0; ai < 2; ++ai)
#pragma unroll
        for (int m = 0; m < 4; ++m) {
            const int rl = ai * HALF + wr * 64 + m * 16 + fr, pp = p0 + rl;
            f32x4 v[4];
#pragma unroll
            for (int nt = 0; nt < 4; ++nt) v[nt] = acc[ai][nt >> 1][m][nt & 1];
            if (do_norm) {
                float ss = 0.f;
#pragma unroll
                for (int nt = 0; nt < 4; ++nt) ss += v[nt][0] * v[nt][0] + v[nt][1] * v[nt][1] + v[nt][2] * v[nt][2] + v[nt][3] * v[nt][3];
                ss += __shfl_xor(ss, 16); ss += __shfl_xor(ss, 32);
                const float rstd = rsqrtf(ss * (1.f / 64.f) + EPS);
#pragma unroll
                for (int nt = 0; nt < 4; ++nt) { const f32x4 gv = *(const f32x4*)(g + nt * 16 + fq * 4); v[nt] = v[nt] * rstd * gv; }
            }
            if (do_rope && latent) {
                const int tt = pp - LC, pr = tt >> 6, pc = tt & 63;
                const f32x4 c0 = *(const f32x4*)(rt + pr * 16 + fq * 4), s0 = *(const f32x4*)(rt + 1024 + pr * 16 + fq * 4);
                const f32x4 c1 = *(const f32x4*)(rt + pc * 16 + fq * 4), s1 = *(const f32x4*)(rt + 1024 + pc * 16 + fq * 4);
                const f32x4 a1 = v[0], a2 = v[1], b1 = v[2], b2 = v[3];
                v[0] = a1 * c0 - a2 * s0; v[1] = a2 * c0 + a1 * s0;
                v[2] = b1 * c1 - b2 * s1; v[3] = b2 * c1 + b1 * s1;
            }
            if (kind == 0) {
                bf16_t* d = Qb + (size_t)(grow0 + rl) * 1024 + cidx * 64 + fq * 4;
#pragma unroll
                for (int nt = 0; nt < 4; ++nt) { const f32x4 o = v[nt] * qscale; *(u32x2*)(d + nt * 16) = (u32x2){pk2(o[0], o[1]), pk2(o[2], o[3])}; }
            } else if (kind == 1) {
                bf16_t* d = Kb + (size_t)(grow0 + rl) * 640 + cidx * 64 + fq * 4;
#pragma unroll
                for (int nt = 0; nt < 4; ++nt) *(u32x2*)(d + nt * 16) = (u32x2){pk2(v[nt][0], v[nt][1]), pk2(v[nt][2], v[nt][3])};
            } else {
                bf16_t* d = Vt + ((size_t)(b * 10 + cidx) * 64 + fq * 4) * P + pp;
#pragma unroll
                for (int nt = 0; nt < 4; ++nt) {
                    const unsigned u0 = pk2(v[nt][0], v[nt][1]), u1 = pk2(v[nt][2], v[nt][3]);
                    bf16_t* dd = d + (size_t)(nt * 16) * P;
                    dd[0] = (bf16_t)(u0 & 0xffffu); dd[P] = (bf16_t)(u0 >> 16); dd[2 * P] = (bf16_t)(u1 & 0xffffu); dd[3 * P] = (bf16_t)(u1 >> 16);
                }
            }
            asm volatile("" ::: "memory");
        }
    }
};
template <class Epi, class Sched, bool ALIGN_EPI = false, bool SP2 = false>
__device__ __forceinline__ void gemm_phase(PG8_LAS unsigned char* lds, const Gemm g, const Sched& S, const Epi& E, const int tid) {
    const int wid = __builtin_amdgcn_readfirstlane(tid >> 6), lane = tid & 63, wr = wid >> 2, wc = wid & 3, fr = lane & 15, fq = lane >> 4;
    const int K = g.K, nt = g.kLen / BK;
    unsigned voffA[2], voffB[2];
#pragma unroll
    for (int i = 0; i < 2; ++i) { int R, C; stage_rc(tid * 16 + i * 8192, R, C); const int Rb = Epi::PERM ? ((R & ~31) + perm32(R & 31)) : R;
        voffA[i] = (unsigned)(R * K + C) * 2u; voffB[i] = (unsigned)(Rb * K + C) * 2u; }
    const size_t kstep = (size_t)(BK * 2);
    const size_t hstep = (size_t)HALF * K * 2;
    const size_t tstep = 2 * hstep;
    const unsigned ldsw = (unsigned)wid * 1024u;
    const int aoff = lds_byte(wr * 64 + fr, fq * 8), boff = lds_byte(wc * 32 + fr, fq * 8);
#define PG8_SA(b, h) (((b) * 2 + (h)) * HTB)
#define PG8_SB(b, h) ((4 + (b) * 2 + (h)) * HTB)
#define PG8_STAGE(bufoff, gbase, voff) do { _Pragma("unroll") for (int _i = 0; _i < 2; ++_i) \
        __builtin_amdgcn_global_load_lds((const unsigned*)((const char*)(gbase) + (voff)[_i]), (PG8_LAS unsigned*)(lds + (bufoff) + ldsw + _i * 8192), 16, 0, 0); } while (0)
#define PG8_LDA(dst, b, h) do { _Pragma("unroll") for (int m = 0; m < 4; ++m) _Pragma("unroll") for (int k = 0; k < 2; ++k) dst[m][k] = *(const PG8_LAS bf16x8*)(lds + PG8_SA(b, h) + aoff + m * 2048 + k * 1024); } while (0)
#define PG8_LDB(dst, b, h) do { _Pragma("unroll") for (int n = 0; n < 2; ++n) _Pragma("unroll") for (int k = 0; k < 2; ++k) dst[n][k] = *(const PG8_LAS bf16x8*)(lds + PG8_SB(b, h) + boff + n * 2048 + k * 1024); } while (0)
#define PG8_MMA(ai, bj, At, Bt) do { __builtin_amdgcn_s_setprio(1); _Pragma("unroll") for (int m = 0; m < 4; ++m) _Pragma("unroll") for (int n = 0; n < 2; ++n) _Pragma("unroll") for (int k = 0; k < 2; ++k) \
        acc[ai][bj][m][n] = __builtin_amdgcn_mfma_f32_16x16x32_bf16(Bt[n][k], At[m][k], acc[ai][bj][m][n], 0, 0, 0); __builtin_amdgcn_s_setprio(0); } while (0)
#define PG8_WAIT_V(n) asm volatile("s_waitcnt vmcnt(" #n ")" ::: "memory")
#define PG8_WAIT_L(n) asm volatile("s_waitcnt lgkmcnt(" #n ")" ::: "memory")
#define PG8_BAR __builtin_amdgcn_s_barrier()
#define PG8_SCHED __builtin_amdgcn_sched_barrier(0)
    Unit cur, nxt; int ui = 0;
    if (!S.next(0, cur)) return;
    f32x4 acc[2][2][4][2];
#pragma unroll
    for (int a = 0; a < 2; ++a)
#pragma unroll
        for (int b = 0; b < 2; ++b)
#pragma unroll
            for (int m = 0; m < 4; ++m)
#pragma unroll
                for (int n = 0; n < 2; ++n) acc[a][b][m][n] = (f32x4){0.f, 0.f, 0.f, 0.f};
    bf16x8 At[4][2], B0[2][2], B1[2][2];
    const char* cA = (const char*)g.A + (size_t)cur.pa * tstep + (size_t)cur.ks * g.kLen * 2; const char* cB = (const char*)g.Bt + (size_t)cur.pn * tstep + (size_t)cur.ks * g.kLen * 2;
    S.a_ready(cur);
    if constexpr (SP2) {
        PG8_STAGE(PG8_SB(0, 0), cB, voffB); PG8_STAGE(PG8_SB(0, 1), cB + hstep, voffB); PG8_STAGE(PG8_SA(0, 0), cA, voffA); PG8_STAGE(PG8_SA(0, 1), cA + hstep, voffA);
        if (wr == 1) PG8_BAR;
        PG8_WAIT_V(2); PG8_BAR;
        PG8_STAGE(PG8_SB(1, 0), cB + kstep, voffB); PG8_STAGE(PG8_SA(1, 0), cA + kstep, voffA); PG8_STAGE(PG8_SB(1, 1), cB + hstep + kstep, voffB);
        PG8_WAIT_V(6); PG8_BAR;
    } else {
        PG8_STAGE(PG8_SB(0, 0), cB, voffB); PG8_STAGE(PG8_SA(0, 0), cA, voffA); PG8_STAGE(PG8_SB(0, 1), cB + hstep, voffB); PG8_STAGE(PG8_SA(0, 1), cA + hstep, voffA);
        if (wr == 1) PG8_BAR;
        PG8_WAIT_V(4); PG8_BAR;
        PG8_STAGE(PG8_SB(1, 0), cB + kstep, voffB); PG8_STAGE(PG8_SA(1, 0), cA + kstep, voffA); PG8_STAGE(PG8_SB(1, 1), cB + hstep + kstep, voffB);
        PG8_WAIT_V(6); PG8_BAR;
    }
    for (;;) {
        const bool has_next = S.next(ui + 1, nxt);
        const char* nA = has_next ? (const char*)g.A + (size_t)nxt.pa * tstep + (size_t)nxt.ks * g.kLen * 2 : cA; const char* nB = has_next ? (const char*)g.Bt + (size_t)nxt.pn * tstep + (size_t)nxt.ks * g.kLen * 2 : cB;
        for (int t = 0; t < nt; t += 2) {
            const bool last = (t == nt - 2);
            const char* a1 = cA + (size_t)(t + 1) * kstep;
            const char* a2 = last ? nA : cA + (size_t)(t + 2) * kstep; const char* b2 = last ? nB : cB + (size_t)(t + 2) * kstep;
            const char* a3 = a2 + kstep; const char* b3 = b2 + kstep;
            if (last && has_next) S.a_ready(nxt);
            if constexpr (SP2) {
            PG8_LDB(B0, 0, 0); PG8_LDB(B1, 0, 1); PG8_SCHED; PG8_LDA(At, 0, 0); PG8_STAGE(PG8_SA(1, 1), a1 + hstep, voffA);
            PG8_WAIT_V(8); PG8_WAIT_L(0); PG8_BAR; PG8_MMA(0, 0, At, B0); PG8_MMA(0, 1, At, B1); PG8_BAR; PG8_SCHED;
            PG8_LDA(At, 0, 1); PG8_STAGE(PG8_SB(0, 0), b2, voffB); PG8_STAGE(PG8_SB(0, 1), b2 + hstep, voffB); PG8_STAGE(PG8_SA(0, 0), a2, voffA);
            PG8_WAIT_V(8); PG8_WAIT_L(0); PG8_BAR; PG8_MMA(1, 0, At, B0); PG8_MMA(1, 1, At, B1); PG8_BAR; PG8_SCHED;
            PG8_LDB(B0, 1, 0); PG8_LDB(B1, 1, 1); PG8_SCHED; PG8_LDA(At, 1, 0); PG8_STAGE(PG8_SA(0, 1), a2 + hstep, voffA);
            PG8_WAIT_V(8); PG8_WAIT_L(0); PG8_BAR; PG8_MMA(0, 0, At, B0); PG8_MMA(0, 1, At, B1); PG8_BAR; PG8_SCHED;
            PG8_LDA(At, 1, 1); PG8_STAGE(PG8_SB(1, 0), b3, voffB); PG8_STAGE(PG8_SB(1, 1), b3 + hstep, voffB); PG8_STAGE(PG8_SA(1, 0), a3, voffA);
            PG8_WAIT_V(8); PG8_WAIT_L(0); PG8_BAR; PG8_MMA(1, 0, At, B0); PG8_MMA(1, 1, At, B1); PG8_BAR; PG8_SCHED;
            } else {
            PG8_LDB(B0, 0, 0); PG8_SCHED; PG8_LDA(At, 0, 0); PG8_STAGE(PG8_SA(1, 1), a1 + hstep, voffA);
            PG8_WAIT_L(8); PG8_BAR; PG8_WAIT_L(0); PG8_MMA(0, 0, At, B0); PG8_BAR; PG8_SCHED;
            PG8_LDB(B1, 0, 1); PG8_STAGE(PG8_SB(0, 0), b2, voffB);
            PG8_BAR; PG8_WAIT_L(0); PG8_MMA(0, 1, At, B1); PG8_BAR;
            PG8_LDA(At, 0, 1); PG8_STAGE(PG8_SA(0, 0), a2, voffA);
            PG8_BAR; PG8_WAIT_L(0); PG8_MMA(1, 0, At, B0); PG8_BAR; PG8_SCHED;
            PG8_STAGE(PG8_SB(0, 1), b2 + hstep, voffB);
            PG8_WAIT_V(6); PG8_BAR; PG8_MMA(1, 1, At, B1); PG8_BAR;
            PG8_LDB(B0, 1, 0); PG8_SCHED; PG8_LDA(At, 1, 0); PG8_STAGE(PG8_SA(0, 1), a2 + hstep, voffA);
            PG8_WAIT_L(8); PG8_BAR; PG8_WAIT_L(0); PG8_MMA(0, 0, At, B0); PG8_BAR; PG8_SCHED;
            PG8_LDB(B1, 1, 1); PG8_STAGE(PG8_SB(1, 0), b3, voffB);
            PG8_BAR; PG8_WAIT_L(0); PG8_MMA(0, 1, At, B1); PG8_BAR;
            PG8_LDA(At, 1, 1); PG8_STAGE(PG8_SA(1, 0), a3, voffA);
            PG8_BAR; PG8_WAIT_L(0); PG8_MMA(1, 0, At, B0); PG8_BAR; PG8_SCHED;
            PG8_STAGE(PG8_SB(1, 1), b3 + hstep, voffB);
            PG8_WAIT_V(6); PG8_BAR; PG8_MMA(1, 1, At, B1); PG8_BAR;
            }
        }
        if constexpr (ALIGN_EPI) { if (wr == 0) PG8_BAR; }
        if constexpr (!Epi::AFTER_DRAIN) { E(acc, cur, wr, wc, fr, fq); S.done(cur); }
        if (!has_next) break;
#pragma unroll
        for (int a = 0; a < 2; ++a)
#pragma unroll
            for (int b = 0; b < 2; ++b)
#pragma unroll
                for (int m = 0; m < 4; ++m)
#pragma unroll
                    for (int n = 0; n < 2; ++n) acc[a][b][m][n] = (f32x4){0.f, 0.f, 0.f, 0.f};
        cur = nxt; cA = nA; cB = nB; ++ui;
        if constexpr (ALIGN_EPI) { if (wr == 1) PG8_BAR; }
    }
    PG8_WAIT_V(0);
    if constexpr (!ALIGN_EPI) { if (wr == 0) PG8_BAR; }
    PG8_BAR;
    if constexpr (Epi::AFTER_DRAIN) { E.fused(acc, cur, wr, wc, fr, fq, lds, wid, lane); S.done(cur); }
#undef PG8_SA
#undef PG8_SB
#undef PG8_STAGE
#undef PG8_LDA
#undef PG8_LDB
#undef PG8_MMA
#undef PG8_WAIT_V
#undef PG8_WAIT_L
#undef PG8_BAR
#undef PG8_SCHED
}}

DI void p0_transpose(const Ctx& cx, const float* W, bf16_t* Wt, int K, int N, int tk, int tn, int perm, unsigned char* lds) {
  float* s = (float*)lds;
  const int t = cx.tid;
  __syncthreads();
#pragma unroll
  for (int i = 0; i < 8; ++i) { const int k = i * 8 + (t >> 6), n = t & 63; s[k * 65 + n] = W[(size_t)(tk * 64 + k) * N + tn * 64 + n]; }
  __syncthreads();
#pragma unroll
  for (int i = 0; i < 4; ++i) { const int n = i * 16 + (t >> 5), kk = (t & 31) * 2;
    const int orow = perm ? (256 * (tn >> 2) + 128 * (n >> 5) + 32 * (tn & 3) + (n & 31)) : tn * 64 + n;
    *(unsigned*)(Wt + (size_t)orow * K + tk * 64 + kk) = pk2(s[kk * 65 + n], s[(kk + 1) * 65 + n]); }
}
DI void p0_mod(const Ctx& cx, const Params& p, int item, unsigned char* lds) {
  float* sS = (float*)lds;
  float* red = (float*)(lds + 9 * 1024 * 4);
  const int t = cx.tid, lane = t & 63, w = t >> 6;
  const int l = item / 96, cc = item % 96;
  __syncthreads();
  for (int e = t; e < 9 * 1024; e += NTHR) { const int i = e >> 10, k = e & 1023; const float v = (i < 8) ? p.c[i * 1024 + k] : p.c_ctx[k]; sS[e] = v / (1.f + __expf(-v)); }
  __syncthreads();
  float acc[9];
#pragma unroll
  for (int i = 0; i < 9; ++i) acc[i] = 0.f;
  const float* wp = p.w_mod + (size_t)l * 1024 * 6144 + cc * 64 + lane;
  for (int k = w * 128; k < w * 128 + 128; ++k) { const float wv = wp[(size_t)k * 6144];
#pragma unroll
    for (int i = 0; i < 9; ++i) acc[i] += sS[i * 1024 + k] * wv; }
#pragma unroll
  for (int i = 0; i < 9; ++i) red[(w * 9 + i) * 64 + lane] = acc[i];
  __syncthreads();
  float* mod = (float*)(p.ws + OFF_MOD);
  for (int e = t; e < 576; e += NTHR) { const int i = e >> 6, n = e & 63;
    float v = p.b_mod[l * 6144 + cc * 64 + n];
#pragma unroll
    for (int ww = 0; ww < 8; ++ww) v += red[(ww * 9 + i) * 64 + n];
    mod[(size_t)(l * 9 + i) * 6144 + cc * 64 + n] = v; }
}
DI void phase_prep(const Ctx& cx, const Params& p, unsigned char* lds, int l, int misc) {
  const int N_MISC = misc ? 193 : 0;
  constexpr int TW_IN = 16 * 36, TW_OUT = 16 * 16, TW_1 = 16 * 64, TW_2 = 64 * 16, TW_L = TW_IN + TW_OUT + TW_1 + TW_2;
  const int total = N_MISC + TW_L;
  for (int it = cx.bid; it < total; it += cx.nb) {
    if (it < N_MISC) {
      if (it < 192) p0_mod(cx, p, it, lds);
      else { float* rt = (float*)(p.ws + OFF_ROPE);
        for (int e = cx.tid; e < 1024; e += NTHR) { const int pos = e >> 4, f = e & 15; const float inv = powf(10000.f, -(float)f / 16.f); const float ang = (float)pos * inv;
          rt[e] = cosf(ang); rt[1024 + e] = sinf(ang); } }
    } else {
      int i = it - N_MISC;
      if (i < TW_IN) { p0_transpose(cx, p.w_in + (size_t)l * DM * INW, (bf16_t*)(p.ws + OFF_WIN), DM, INW, i / 36, i % 36, 1, lds); }
      else if (i < TW_IN + TW_OUT) { i -= TW_IN; p0_transpose(cx, p.w_out + (size_t)l * DM * DM, (bf16_t*)(p.ws + OFF_WOUT), DM, DM, i / 16, i % 16, 0, lds); }
      else if (i < TW_IN + TW_OUT + TW_1) { i -= TW_IN + TW_OUT; p0_transpose(cx, p.w_mlp_in + (size_t)l * DM * FF, (bf16_t*)(p.ws + OFF_W1), DM, FF, i / 64, i % 64, 0, lds); }
      else { i -= TW_IN + TW_OUT + TW_1; p0_transpose(cx, p.w_mlp_out + (size_t)l * FF * DM, (bf16_t*)(p.ws + OFF_W2), FF, DM, i / 16, i % 16, 0, lds); }
    }
  }
}

DI float wave_sum(float v) {
#pragma unroll
  for (int o = 32; o >= 1; o >>= 1) v += __shfl_xor(v, o);
  return v;
}
DI void phase_rowpass(const Ctx& cx, const Params& p, int mode, int layer) {
  const int lane = cx.tid & 63, w = cx.tid >> 6;
  const bool latent_only = (layer == 1 && mode != 0);
  const int nrows = latent_only ? NB * T : R;
  float* X = (float*)(p.ws + OFF_X);
  bf16_t* HA = (bf16_t*)(p.ws + OFF_A);
  const bf16_t* MF = (const bf16_t*)(p.ws + OFF_B);
  const float* mod = (const float*)(p.ws + OFF_MOD);
  for (int it = cx.bid * NWV + w; it < nrows; it += cx.nb * NWV) {
    const int row = latent_only ? ((it >> 11) * P + LC + (it & 2047)) : it;
    const int b = row / P, pp = row - b * P, mi = (pp < LC) ? 8 : b;
    const float* modp = mod + (size_t)(layer * 9 + mi) * 6144;
    const float* resid;
    if (mode == 0 || (mode == 1 && layer == 0)) resid = (pp < LC) ? p.ctx + ((size_t)b * LC + pp) * DM : p.x + ((size_t)b * T + pp - LC) * DM;
    else resid = X + (size_t)row * DM;
    f32x4 xv[4];
#pragma unroll
    for (int i = 0; i < 4; ++i) xv[i] = *(const f32x4*)(resid + lane * 4 + 256 * i);
    if (mode != 0) {
      const bf16_t* src = (mode == 1 ? MF : HA) + (size_t)row * DM;
      const float* gate = modp + (mode == 1 ? 2048 : 5120);
      const float* na = p.norm_g + (size_t)(layer * 4 + (mode == 1 ? 1 : 3)) * DM;
      f32x4 mv[4]; float ss = 0.f;
      if (mode == 2 && layer == 0 && pp < LC) {
        const bf16_t* sl = (const bf16_t*)(p.ws + OFF_SLAB) + (size_t)(b * LC + pp) * DM;
#pragma unroll
        for (int i = 0; i < 4; ++i) mv[i] = (f32x4){0.f, 0.f, 0.f, 0.f};
        for (int k8 = 0; k8 < 8; ++k8) {
#pragma unroll
          for (int i = 0; i < 4; ++i) { const u32x2 u = *(const u32x2*)(sl + (size_t)k8 * NB * LC * DM + lane * 4 + 256 * i); mv[i] = mv[i] + (f32x4){bflo(u.x), bfhi(u.x), bflo(u.y), bfhi(u.y)}; }
        }
      } else {
#pragma unroll
        for (int i = 0; i < 4; ++i) { const u32x2 u = *(const u32x2*)(src + lane * 4 + 256 * i); mv[i] = (f32x4){bflo(u.x), bfhi(u.x), bflo(u.y), bfhi(u.y)}; }
      }
#pragma unroll
      for (int i = 0; i < 4; ++i) ss += mv[i][0] * mv[i][0] + mv[i][1] * mv[i][1] + mv[i][2] * mv[i][2] + mv[i][3] * mv[i][3];
      ss = wave_sum(ss);
      const float rstd = rsqrtf(ss * (1.f / DM) + EPS);
#pragma unroll
      for (int i = 0; i < 4; ++i) { const f32x4 g = *(const f32x4*)(gate + lane * 4 + 256 * i), n = *(const f32x4*)(na + lane * 4 + 256 * i);
        xv[i] = xv[i] + g * (mv[i] * rstd * n); }
      float* dst = (mode == 2 && layer == 1) ? p.out + ((size_t)b * T + pp - LC) * DM : X + (size_t)row * DM;
#pragma unroll
      for (int i = 0; i < 4; ++i) *(f32x4*)(dst + lane * 4 + 256 * i) = xv[i];
    }
    if (!(mode == 2 && layer == 1)) {
      const float* nb; const float* sh; const float* sc;
      if (mode == 0) { nb = p.norm_g + (size_t)(layer * 4 + 0) * DM; sh = modp; sc = modp + 1024; }
      else if (mode == 1) { nb = p.norm_g + (size_t)(layer * 4 + 2) * DM; sh = modp + 3072; sc = modp + 4096; }
      else { const float* modn = mod + (size_t)((layer + 1) * 9 + mi) * 6144; nb = p.norm_g + (size_t)((layer + 1) * 4 + 0) * DM; sh = modn; sc = modn + 1024; }
      float ss = 0.f;
#pragma unroll
      for (int i = 0; i < 4; ++i) ss += xv[i][0] * xv[i][0] + xv[i][1] * xv[i][1] + xv[i][2] * xv[i][2] + xv[i][3] * xv[i][3];
      ss = wave_sum(ss);
      const float rstd = rsqrtf(ss * (1.f / DM) + EPS);
      bf16_t* hd = HA + (size_t)row * DM;
#pragma unroll
      for (int i = 0; i < 4; ++i) { const f32x4 n = *(const f32x4*)(nb + lane * 4 + 256 * i), s1 = *(const f32x4*)(sc + lane * 4 + 256 * i), s0 = *(const f32x4*)(sh + lane * 4 + 256 * i);
        const f32x4 hv = (xv[i] * rstd * n) * (1.f + s1) + s0;
        *(u32x2*)(hd + lane * 4 + 256 * i) = (u32x2){pk2(hv[0], hv[1]), pk2(hv[2], hv[3])}; }
    }
  }
}

constexpr int VS_OFF = 16384, ABUF = 36864  , RPB_OFF = 2 * ABUF;
template <int MODE>
DI void attn_item(const Ctx& cx, const Params& p, unsigned char* lds, int b, int h, int q0, int n0, int t1s, int t1e) {
  constexpr int NDB = (MODE == 1) ? 4 : 2;
  constexpr int NK = (MODE == 1) ? 2 : 1;
  constexpr int NVC = NDB / 2;
  const int t = cx.tid, lane = t & 63, w = t >> 6, r32 = lane & 31, hh = lane >> 5;
  const bf16_t* Qb = (const bf16_t*)(p.ws + OFF_Q); const bf16_t* Kb = (const bf16_t*)(p.ws + OFF_K); const bf16_t* Vt = (const bf16_t*)(p.ws + OFF_VT);
  bf16_t* Ob = (bf16_t*)(p.ws + OFF_A);
  int cq, ck, cv, kidx, qoff, ocol;
  if (MODE == 0 || MODE == 2) { cq = h; ck = h >> 2; cv = h >> 2; kidx = 0; qoff = 32 * w; ocol = h * 64; }
  else if (MODE == 3) { cq = 8 + h; ck = 2 + h; cv = 2 + h; kidx = 0; qoff = 32 * w; ocol = 512 + h * 64; }
  else { const int j = w >> 2; cq = 8 + 2 * h + j; ck = 2 + 2 * h; cv = 2 + 2 * h; kidx = j; qoff = 32 * (w & 3); ocol = 512 + h * 128; }
  const size_t rowbase = (size_t)b * P;
  const int qp = q0 + qoff + r32;
  bf16x8 qf[4];
  { const bf16_t* qptr = Qb + (rowbase + qp) * 1024 + cq * 64 + hh * 8;
#pragma unroll
    for (int ks = 0; ks < 4; ++ks) qf[ks] = *(const bf16x8*)(qptr + ks * 16); }
  float m_run = -1e30f, l_run = 0.f;
  if (MODE == 2) { m_run = p.sink_c[h] * LOG2E; l_run = hh ? 0.f : 1.f; }
  f32x16 O[NDB];
#pragma unroll
  for (int db = 0; db < NDB; ++db)
#pragma unroll
    for (int i = 0; i < 16; ++i) O[db][i] = 0.f;
  __syncthreads();
  const float* rpbs = (const float*)(lds + RPB_OFF);
  if (MODE == 3) { float* rp = (float*)(lds + RPB_OFF); for (int i = t; i < 465; i += NTHR) rp[i] = p.rpb_d[h * 465 + i] * LOG2E; }
  const int srow = t >> 3, skc = t & 7;
  const unsigned ksw = (unsigned)(srow * 128 + ((skc ^ ((srow >> 1) & 7)) << 4));
  const int ksx = (r32 >> 1) & 7;
  u32x4 kreg[NK], vreg[NVC];
  const int ntl = n0 + (t1e - t1s);
  auto tile_of = [&](int i) { return i < n0 ? i : t1s + (i - n0); };
  auto prefetch = [&](int tile) {
    const size_t key0 = rowbase + (size_t)tile * 64;
#pragma unroll
    for (int kk = 0; kk < NK; ++kk) kreg[kk] = *(const u32x4*)(Kb + (key0 + srow) * 640 + (ck + kk) * 64 + skc * 8);
#pragma unroll
    for (int i = 0; i < NVC; ++i) vreg[i] = *(const u32x4*)(Vt + ((size_t)(b * 10 + cv) * 64 + srow + 64 * i) * P + tile * 64 + skc * 8);
  };
  auto stage = [&](int buf) {
    unsigned char* lb = lds + buf * ABUF;
#pragma unroll
    for (int kk = 0; kk < NK; ++kk) *(u32x4*)(lb + kk * 8192 + ksw) = kreg[kk];
#pragma unroll
    for (int i = 0; i < NVC; ++i) { unsigned char* d = lb + VS_OFF + (srow + 64 * i) * 136 + skc * 16;
      *(u32x2*)d = (u32x2){vreg[i].x, vreg[i].y}; *(u32x2*)(d + 8) = (u32x2){vreg[i].z, vreg[i].w}; }
  };
  const int qpos = qp - LC;
  const int qw0 = q0 - LC + qoff;
  const int qr = qpos >> 6, qc = qpos & 63;
  auto xmax32 = [&](float v) {
    const u32x2 r = __builtin_amdgcn_permlane32_swap(__float_as_uint(v), __float_as_uint(v), false, false);
    return fmaxf(__uint_as_float(r.x), __uint_as_float(r.y));
  };
  auto qk = [&](const unsigned char* lb, int kt, f32x16& S) {
    bf16x8 kf[4];
#pragma unroll
    for (int ks = 0; ks < 4; ++ks) kf[ks] = *(const bf16x8*)(lb + kidx * 8192 + (kt * 32 + r32) * 128 + (((2 * ks + hh) ^ ksx) << 4));
#pragma unroll
    for (int i = 0; i < 16; ++i) S[i] = 0.f;
#pragma unroll
    for (int ks = 0; ks < 4; ++ks) S = __builtin_amdgcn_mfma_f32_32x32x16_bf16(kf[ks], qf[ks], S, 0, 0, 0);
  };
  auto softmax_step = [&](f32x16& S, int tile, int kt, int krow_, bf16x8 (&pf)[2]) {
    if (MODE == 2 && tile >= 4) {
      const int dbase = (tile - 4) * 64 + 4 * hh - qpos + 128;
#pragma unroll
      for (int i = 0; i < 16; ++i) { const int ci = kt * 32 + (i & 3) + 8 * (i >> 2); if ((unsigned)(dbase + ci) > 256u) S[i] = -1e30f; }
    }
    if (MODE == 3 && tile >= 4) {
      const int vbase = 4 * hh - clampi(qc - 8, 0, 48);
      const float* rp = rpbs + (krow_ - qr + 7) * 31 + 15 + 4 * hh - qc;
      float bv[16];
#pragma unroll
      for (int i = 0; i < 16; ++i) bv[i] = rp[kt * 32 + (i & 3) + 8 * (i >> 2)];
#pragma unroll
      for (int i = 0; i < 16; ++i) { const int ci = kt * 32 + (i & 3) + 8 * (i >> 2); const bool valid = (unsigned)(vbase + ci) < 16u;
        S[i] = valid ? S[i] + bv[i] : -1e30f; }
    }
    float mx = S[0];
#pragma unroll
    for (int i = 1; i < 16; ++i) mx = fmaxf(mx, S[i]);
    mx = xmax32(mx);
    const float m_new = fmaxf(m_run, mx);
    const bool grew = m_new > m_run;
    const float alpha = __builtin_amdgcn_exp2f(m_run - m_new);
    const f32x2 mm = {m_new, m_new};
    f32x2 ps2 = {0.f, 0.f};
#pragma unroll
    for (int i = 0; i < 16; i += 2) { f32x2 v = (f32x2){S[i], S[i + 1]} - mm; v.x = __builtin_amdgcn_exp2f(v.x); v.y = __builtin_amdgcn_exp2f(v.y); ps2 += v; S[i] = v.x; S[i + 1] = v.y; }
    l_run = l_run * alpha + (ps2.x + ps2.y); m_run = m_new;
    if (__builtin_amdgcn_ballot_w64(grew) != 0ull) {
#pragma unroll
      for (int db = 0; db < NDB; ++db)
#pragma unroll
        for (int i = 0; i < 16; ++i) O[db][i] *= alpha;
    }
#pragma unroll
    for (int s = 0; s < 2; ++s) {
      u32x4 u; u.x = pk2(S[8 * s + 0], S[8 * s + 1]); u.y = pk2(S[8 * s + 2], S[8 * s + 3]); u.z = pk2(S[8 * s + 4], S[8 * s + 5]); u.w = pk2(S[8 * s + 6], S[8 * s + 7]);
      pf[s] = __builtin_bit_cast(bf16x8, u);
    }
  };
  auto pv = [&](const unsigned char* lb, int kt, const bf16x8 (&pf)[2]) {
    bf16x8 vf[NDB][2];
#pragma unroll
    for (int db = 0; db < NDB; ++db)
#pragma unroll
      for (int s = 0; s < 2; ++s) {
        const unsigned char* vb = lb + VS_OFF + (db * 32 + r32) * 136 + (kt * 32 + 16 * s + 4 * hh) * 2;
        const s16x4 lo = *(const s16x4*)vb, hi = *(const s16x4*)(vb + 16);
        vf[db][s] = __builtin_shufflevector(lo, hi, 0, 1, 2, 3, 4, 5, 6, 7);
      }
#pragma unroll
    for (int db = 0; db < NDB; ++db)
#pragma unroll
      for (int s = 0; s < 2; ++s) O[db] = __builtin_amdgcn_mfma_f32_32x32x16_bf16(vf[db][s], pf[s], O[db], 0, 0, 0);
    __builtin_amdgcn_sched_group_barrier(0x100, NDB * 2, 0);
    __builtin_amdgcn_sched_group_barrier(0x008, NDB * 2, 0);
  };
  auto compute = [&](int tile, int buf) {
    const unsigned char* lb = lds + buf * ABUF;
    int krow_ = 0;
    if (MODE == 3 && tile >= 4) { krow_ = tile - 4; const int rs = clampi((qw0 >> 6) - 4, 0, 24); if (krow_ < rs || krow_ >= rs + 8) return; }
    if (MODE == 2 && tile >= 4) { const int k0 = (tile - 4) * 64; if (k0 > qw0 + 31 + 128 || k0 + 63 < qw0 - 128) return; }
    f32x16 S0, S1; bf16x8 pf0[2], pf1[2];
    if (MODE == 1) {
      qk(lb, 0, S0); softmax_step(S0, tile, 0, krow_, pf0); pv(lb, 0, pf0);
      __builtin_amdgcn_sched_barrier(0);
      qk(lb, 1, S1); softmax_step(S1, tile, 1, krow_, pf1); pv(lb, 1, pf1);
      return;
    }
    qk(lb, 0, S0);
    qk(lb, 1, S1);
    __builtin_amdgcn_sched_group_barrier(0x100, 8, 0);
    __builtin_amdgcn_sched_group_barrier(0x008, 8, 0);
    __builtin_amdgcn_sched_barrier(0);
    softmax_step(S0, tile, 0, krow_, pf0);
    __builtin_amdgcn_sched_barrier(0);
    pv(lb, 0, pf0);
    __builtin_amdgcn_sched_barrier(0);
    softmax_step(S1, tile, 1, krow_, pf1);
    __builtin_amdgcn_sched_barrier(0);
    pv(lb, 1, pf1);
  };
  prefetch(tile_of(0));
  stage(0);
  if (ntl > 1) prefetch(tile_of(1));
  __syncthreads();
  for (int i = 0; i < ntl; ++i) {
    if (i + 1 < ntl) stage((i + 1) & 1);
    if (i + 2 < ntl) prefetch(tile_of(i + 2));
    __builtin_amdgcn_sched_barrier(0);
    compute(tile_of(i), i & 1);
    __syncthreads();
  }
  { const u32x2 r = __builtin_amdgcn_permlane32_swap(__float_as_uint(l_run), __float_as_uint(l_run), false, false); l_run = __uint_as_float(r.x) + __uint_as_float(r.y); }
  const float inv = 1.f / l_run;
  bf16_t* orow = Ob + (rowbase + qp) * 1024 + ocol;
  if (MODE != 1) {
#pragma unroll
    for (int db = 0; db < NDB; ++db)
#pragma unroll
      for (int g = 0; g < 4; ++g) {
        const int dv = db * 32 + 8 * g + 4 * hh;
        *(u32x2*)(orow + dv) = (u32x2){pk2(O[db][4 * g] * inv, O[db][4 * g + 1] * inv), pk2(O[db][4 * g + 2] * inv, O[db][4 * g + 3] * inv)};
      }
  } else {
    const float* lp = p.diff_lambda;
    float s1 = lp[lane] * lp[64 + lane], s2 = lp[128 + lane] * lp[192 + lane];
    s1 = wave_sum(s1); s2 = wave_sum(s2);
    const float lam = __expf(s1) - __expf(s2) + 0.2f;
    float* xch = (float*)lds;
    __syncthreads();
    if (w >= 4) {
#pragma unroll
      for (int db = 0; db < NDB; ++db)
#pragma unroll
        for (int i = 0; i < 16; ++i) xch[(db * 32 + crow(i, hh)) * 128 + qoff + r32] = O[db][i] * inv;
    }
    __syncthreads();
    if (w < 4) {
      float ss = 0.f;
#pragma unroll
      for (int db = 0; db < NDB; ++db)
#pragma unroll
        for (int i = 0; i < 16; ++i) { const float o = O[db][i] * inv - lam * xch[(db * 32 + crow(i, hh)) * 128 + qoff + r32]; O[db][i] = o; ss += o * o; }
      ss += __shfl_xor(ss, 32);
      const float rstd = rsqrtf(ss * (1.f / 128.f) + EPS) * 0.8f;
#pragma unroll
      for (int db = 0; db < NDB; ++db)
#pragma unroll
        for (int g = 0; g < 4; ++g) {
          const int dv = db * 32 + 8 * g + 4 * hh;
          const f32x4 sg = *(const f32x4*)(p.diff_subln + dv);
          *(u32x2*)(orow + dv) = (u32x2){pk2(O[db][4 * g] * rstd * sg[0], O[db][4 * g + 1] * rstd * sg[1]), pk2(O[db][4 * g + 2] * rstd * sg[2], O[db][4 * g + 3] * rstd * sg[3])};
        }
    }
  }
}
DI void phase_attn(const Ctx& cx, const Params& p, int layer, unsigned char* lds) {
  const int total = (layer == 0) ? 1152 : 1024;
  for (int idx = cx.bid; idx < total; idx += cx.nb) {
    int mode, b, h, q0, n0 = 4, t1s = 0, t1e = 0;
    if (layer == 0) {
      if (idx < 512) { mode = 0; const int qb = idx & 7; h = (idx >> 3) & 7; b = idx >> 6; q0 = LC + qb * 256; n0 = 36; }
      else if (idx < 1024) { const int i = idx - 512; mode = 1; const int qb = i & 15; h = (i >> 4) & 3; b = i >> 6; q0 = LC + qb * 128; n0 = 36; }
      else if (idx < 1088) { const int i = idx - 1024; mode = 0; h = i & 7; b = i >> 3; q0 = 0; }
      else { const int i = idx - 1088; mode = 1; const int qb = i & 1; h = (i >> 1) & 3; b = i >> 3; q0 = qb * 128; }
    } else {
      const int i = idx & 511; const int qb = i & 7; h = (i >> 3) & 7; b = i >> 6; q0 = LC + qb * 256;
      if (idx < 512) { mode = 3; t1s = 4 + clampi(4 * qb - 4, 0, 24); t1e = 4 + clampi(4 * qb - 1, 0, 24) + 8; }
      else { mode = 2; t1s = 4 + (4 * qb - 2 > 0 ? 4 * qb - 2 : 0); t1e = 4 + (4 * qb + 6 < 32 ? 4 * qb + 6 : 32); }
    }
    if (mode == 0) attn_item<0>(cx, p, lds, b, h, q0, n0, t1s, t1e);
    else if (mode == 1) attn_item<1>(cx, p, lds, b, h, q0, n0, t1s, t1e);
    else if (mode == 2) attn_item<2>(cx, p, lds, b, h, q0, n0, t1s, t1e);
    else attn_item<3>(cx, p, lds, b, h, q0, n0, t1s, t1e);
  }
}

constexpr int NPH = 18;
DI void run_phase(const Ctx& cx, const Params& p, int ph, unsigned char* lds) {
  bf16_t* WIN = (bf16_t*)(p.ws + OFF_WIN); bf16_t* WOUT = (bf16_t*)(p.ws + OFF_WOUT); bf16_t* W1 = (bf16_t*)(p.ws + OFF_W1); bf16_t* W2 = (bf16_t*)(p.ws + OFF_W2);
  bf16_t* RA = (bf16_t*)(p.ws + OFF_A); bf16_t* RB = (bf16_t*)(p.ws + OFF_B); bf16_t* U = (bf16_t*)(p.ws + OFF_U);
  PG8_LAS unsigned char* l3 = (PG8_LAS unsigned char*)lds;
  if (ph == 0) { phase_prep(cx, p, lds, 0, 1); return; }
  if (ph == 1) { phase_rowpass(cx, p, 0, 0); return; }
  const int layer = ph >= 11 ? 1 : 0;
  const int lp = ph - (layer ? 11 : 2);
  pg8::StaticOrder S;
  if (lp == 0) {
    pg8::Gemm g{RA, WIN, R, INW, DM, DM}; S.init(72, 9, cx.nb, cx.bid, 0, 0, 0);
    pg8::EpiInproj E{p.qk_norm_a, (const float*)(p.ws + OFF_ROPE), (bf16_t*)(p.ws + OFF_Q), (bf16_t*)(p.ws + OFF_K), (bf16_t*)(p.ws + OFF_VT), layer};
    pg8::gemm_phase<pg8::EpiInproj, pg8::StaticOrder, true, true>(l3, g, S, E, cx.tid); return;
  }
  if (lp == 1) { phase_attn(cx, p, layer, lds); return; }
  if (lp == 2) {
    pg8::Gemm g{RA, WOUT, R, DM, DM, DM}; S.init(layer ? 64 : 72, 4, cx.nb, cx.bid, layer ? 1 : 0, 0, 0);
    pg8::EpiBf16<0> E{RB, DM, 0};
    pg8::gemm_phase<pg8::EpiBf16<0>, pg8::StaticOrder, true, true>(l3, g, S, E, cx.tid); return;
  }
  if (lp == 3) { phase_rowpass(cx, p, 1, layer); return; }
  const int nmlp = layer ? 2 : 4;
  if (lp < 4 + nmlp) {
    const int pass = (lp - 4) >> 1, isdown = (lp - 4) & 1;
    const int nmt = pass ? 8 : 64, map = pass ? 2 : 1;
    if (!isdown) { pg8::Gemm g{RA, W1, R, FF, DM, DM}; S.init(nmt, 16, cx.nb, cx.bid, map, 0, 1); pg8::EpiBf16<2> E{U, FF, 0};
      pg8::gemm_phase<pg8::EpiBf16<2>, pg8::StaticOrder, true, true>(l3, g, S, E, cx.tid); }
    else if (pass == 0) { pg8::Gemm g{U, W2, R, DM, FF, FF}; S.init(nmt, 4, cx.nb, cx.bid, map, 1, 0); pg8::EpiBf16<0> E{RA, DM, 0};
      pg8::gemm_phase<pg8::EpiBf16<0>, pg8::StaticOrder, true, true>(l3, g, S, E, cx.tid); }
    else {
      pg8::Gemm g{U, W2, R, DM, FF, FF / 8}; S.init(nmt, 4, cx.nb, cx.bid, map, 1, 1, 8); pg8::EpiBf16<0> E{(bf16_t*)(p.ws + OFF_SLAB), DM, (size_t)NB * LC * DM};
      pg8::gemm_phase<pg8::EpiBf16<0>, pg8::StaticOrder, true, true>(l3, g, S, E, cx.tid); }
    return;
  }
  phase_rowpass(cx, p, 2, layer);
  if (layer == 0) phase_prep(cx, p, lds, 1, 0);
}

#if !MULTI
__global__ void __launch_bounds__(NTHR, 2) fwd_megakernel(Params p) {
  extern __shared__ __attribute__((aligned(16))) unsigned char smem[];
  cg::grid_group grid = cg::this_grid();
  XcdBarrier xb; xb.bar = (unsigned*)(p.ws + OFF_BAR); xb.x = xb_xcc_id(); xb.nloc = 0u; xb.nx = 0u;
  if (threadIdx.x == 0) (void)xb_add(&xb.bar[XB_XCNT(xb.x)], 1u);
  if (p.ws == nullptr) grid.sync();
  for (int ph = 0; ph < NPH; ++ph) {
    Ctx cx; cx.tid = threadIdx.x; cx.bid = blockIdx.x; cx.nb = gridDim.x;
    asm volatile("" : "+v"(cx.tid)); asm volatile("" : "+s"(cx.bid));
    run_phase(cx, p, ph, smem);
    if (ph + 1 < NPH) xcd_barrier(xb);
  }
}
#else
__global__ void __launch_bounds__(NTHR, 2) phase_kernel(Params p, int ph) {
  extern __shared__ __attribute__((aligned(16))) unsigned char smem[];
  Ctx cx; cx.tid = threadIdx.x; cx.bid = blockIdx.x; cx.nb = gridDim.x;
  run_phase(cx, p, ph, smem);
}
#endif
#if MULTI
#define MAINK phase_kernel
#else
#define MAINK fwd_megakernel
#endif

extern "C" void kernel_launch(void* const* d_in, const int* in_sizes, int n_in, void* d_out, int out_size, void* d_ws, size_t ws_size, hipStream_t stream) {
  Params p{};
  p.x = (const float*)d_in[0]; p.c = (const float*)d_in[1]; p.ctx = (const float*)d_in[2]; p.c_ctx = (const float*)d_in[3];
  p.w_mod = (const float*)d_in[4]; p.b_mod = (const float*)d_in[5]; p.norm_g = (const float*)d_in[6]; p.w_in = (const float*)d_in[7];
  p.w_out = (const float*)d_in[8]; p.w_mlp_in = (const float*)d_in[9]; p.w_mlp_out = (const float*)d_in[10]; p.qk_norm_a = (const float*)d_in[11];
  p.diff_lambda = (const float*)d_in[12]; p.diff_subln = (const float*)d_in[13]; p.sink_c = (const float*)d_in[14]; p.rpb_d = (const float*)d_in[15];
  p.out = (float*)d_out; p.ws = (unsigned char*)d_ws;
  if (ws_size < WS_END) { fprintf(stderr, "workspace too small: %zu < %zu\n", ws_size, (size_t)WS_END); return; }
  static int grid_blocks = 0;
  if (!grid_blocks) {
    int dev = 0, cus = 0, per_cu = 0;
    hipGetDevice(&dev);
    hipDeviceGetAttribute(&cus, hipDeviceAttributeMultiprocessorCount, dev);
    hipFuncSetAttribute((const void*)MAINK, hipFuncAttributeMaxDynamicSharedMemorySize, LDS_BYTES);
    hipOccupancyMaxActiveBlocksPerMultiprocessor(&per_cu, MAINK, NTHR, LDS_BYTES);
    if (per_cu != 1) fprintf(stderr, "note: occupancy query says %d blocks/CU; launching one per CU\n", per_cu);
    (void)hipGetLastError();
    grid_blocks = cus;
  }
#if MULTI
  for (int ph = 0; ph < NPH; ++ph) phase_kernel<<<dim3(grid_blocks), dim3(NTHR), LDS_BYTES, stream>>>(p, ph);
#else
  hipMemsetAsync(d_ws, 0, 16384, stream);
  void* args[] = {&p};
  hipError_t e = hipLaunchCooperativeKernel((void*)fwd_megakernel, dim3(grid_blocks), dim3(NTHR), args, LDS_BYTES, stream);
  if (e != hipSuccess) fprintf(stderr, "cooperative launch failed: %s (grid %d)\n", hipGetErrorString(e), grid_blocks);
#endif
}
```

```cpp
#include <hip/hip_runtime.h>
#include <hip/hip_cooperative_groups.h>
#include <cstdint>
#include <cstdio>
namespace cg = cooperative_groups;

#ifndef MULTI
#define MULTI 0
#endif

#define DI __device__ __forceinline__
typedef unsigned short bf16_t;
typedef short bf16x8 __attribute__((ext_vector_type(8)));
typedef short s16x4 __attribute__((ext_vector_type(4)));
typedef float f32x2 __attribute__((ext_vector_type(2)));
typedef float f32x4 __attribute__((ext_vector_type(4)));
typedef float f32x16 __attribute__((ext_vector_type(16)));
typedef unsigned u32x2 __attribute__((ext_vector_type(2)));
typedef unsigned u32x4 __attribute__((ext_vector_type(4)));
typedef __bf16 bf16x2_t __attribute__((ext_vector_type(2)));

constexpr int NB = 8, T = 2048, LC = 256, P = 2304, R = NB * P, DM = 1024, INW = 2304, FF = 4096;
constexpr int NTHR = 512, NWV = 8;
constexpr int LDS_BYTES = 131072;
constexpr float EPS = 1e-6f;
constexpr float LOG2E = 1.4426950408889634f;

constexpr size_t OFF_BAR = 0;
constexpr size_t OFF_MOD = 16384;
constexpr size_t OFF_ROPE = OFF_MOD + 2 * 9 * 6144 * 4;
constexpr size_t OFF_W1 = 524288;
constexpr size_t OFF_W2 = OFF_W1 + (size_t)FF * DM * 2;
constexpr size_t OFF_X = OFF_W2 + (size_t)FF * DM * 2;
constexpr size_t OFF_A = OFF_X + (size_t)R * DM * 4;
constexpr size_t OFF_WIN = OFF_A + (size_t)R * DM * 2;
constexpr size_t OFF_WOUT = OFF_WIN + (size_t)INW * DM * 2;
constexpr size_t OFF_B = OFF_WOUT + (size_t)DM * DM * 2;
constexpr size_t OFF_Q = OFF_B;
constexpr size_t OFF_K = OFF_Q + (size_t)R * DM * 2;
constexpr size_t OFF_VT = OFF_K + (size_t)R * 640 * 2;
constexpr size_t OFF_U = OFF_WIN;
constexpr size_t OFF_SLAB = OFF_U + (size_t)NB * LC * FF * 2;
constexpr size_t WS_END = OFF_U + (size_t)16384 * FF * 2;
static_assert(OFF_SLAB + (size_t)8 * NB * LC * DM * 2 <= WS_END, "slabs");
static_assert(OFF_VT + (size_t)R * 640 * 2 <= WS_END && WS_END <= 268435456ull, "workspace map");

struct Params {
  const float *x, *c, *ctx, *c_ctx, *w_mod, *b_mod, *norm_g, *w_in, *w_out, *w_mlp_in, *w_mlp_out, *qk_norm_a, *diff_lambda, *diff_subln, *sink_c, *rpb_d;
  float* out;
  unsigned char* ws;
};

struct Ctx { int tid, bid, nb; };
DI unsigned pk2(float lo, float hi) { f32x2 v = {lo, hi}; return __builtin_bit_cast(unsigned, __builtin_convertvector(v, bf16x2_t)); }
DI float bflo(unsigned u) { return __uint_as_float(u << 16); }
DI float bfhi(unsigned u) { return __uint_as_float(u & 0xffff0000u); }
DI int clampi(int v, int lo, int hi) { return v < lo ? lo : (v > hi ? hi : v); }
DI int crow(int i, int hh) { return (i & 3) + 8 * (i >> 2) + 4 * hh; }

#define XB_TMO      128
#define XB_XCNT(j)  (256  + 64 * (j))
#define XB_XSUB(j)  (1280 + 64 * (j))
#define XB_XGEN(j)  (2304 + 64 * (j))
#define XB_TOP      3328
#define XB_TOPGEN   3392
#define XCD_BAR_WORDS 3456
#define XB_SPIN_CAP (1u << 20)
DI unsigned xb_ld(unsigned* p) { return __hip_atomic_load(p, __ATOMIC_RELAXED, __HIP_MEMORY_SCOPE_AGENT); }
DI unsigned xb_add(unsigned* p, unsigned v) { return __hip_atomic_fetch_add(p, v, __ATOMIC_RELAXED, __HIP_MEMORY_SCOPE_AGENT); }
DI unsigned xb_xcc_id() { return (unsigned)__builtin_amdgcn_s_getreg((3 << 11) | 20) & 0xFu; }
#define XB_SPIN(cond, bar) do { unsigned _sp = 0; while (cond) { __builtin_amdgcn_s_sleep(1); \
    if ((++_sp & 255u) == 0u) { if (xb_ld(&(bar)[XB_TMO])) break; if (_sp > XB_SPIN_CAP) { atomicAdd(&(bar)[XB_TMO], 1u); break; } } } } while (0)
struct XcdBarrier { unsigned* bar; unsigned x; unsigned nloc, nx; };
DI void xcd_barrier_complete(unsigned* bar, unsigned x, unsigned& nloc, unsigned& nx) {
  const unsigned G = gridDim.x * gridDim.y * gridDim.z;
  unsigned sum, cnt, mine, sp = 0u;
  for (;;) {
    sum = 0u; cnt = 0u; mine = 0u;
#pragma unroll
    for (unsigned j = 0; j < 16; ++j) { const unsigned c = xb_ld(&bar[XB_XCNT(j)]); sum += c; cnt += (c > 0u) ? 1u : 0u; mine = (j == x) ? c : mine; }
    if (sum == G) break;
    __builtin_amdgcn_s_sleep(1);
    if ((++sp & 255u) == 0u) { if (xb_ld(&bar[XB_TMO])) break; if (sp > XB_SPIN_CAP) { atomicAdd(&bar[XB_TMO], 1u); break; } }
  }
  nloc = mine > 0u ? mine : 1u; nx = cnt > 0u ? cnt : 1u;
}
DI void xcd_barrier(XcdBarrier& b) {
  asm volatile("s_waitcnt vmcnt(0)" ::: "memory");
  __syncthreads();
  if (threadIdx.x == 0) {
    unsigned* bar = b.bar;
    __builtin_amdgcn_s_waitcnt(0);
    if (b.nloc == 0u) xcd_barrier_complete(bar, b.x, b.nloc, b.nx);
    const unsigned nloc = b.nloc, nx = b.nx;
    const unsigned old = xb_add(&bar[XB_XSUB(b.x)], 1u);
    const unsigned gen = old / nloc;
    if (old + 1u == (gen + 1u) * nloc) {
      __builtin_amdgcn_fence(__ATOMIC_RELEASE, "agent");
      asm volatile("s_waitcnt vmcnt(0)" ::: "memory");
      const unsigned og = xb_add(&bar[XB_TOP], 1u);
      const unsigned tg = og / nx;
      if (og + 1u == (tg + 1u) * nx) xb_add(&bar[XB_TOPGEN], 1u);
      else XB_SPIN(xb_ld(&bar[XB_TOPGEN]) == tg, bar);
      __builtin_amdgcn_fence(__ATOMIC_ACQUIRE, "agent");
      xb_add(&bar[XB_XGEN(b.x)], 1u);
      asm volatile("s_waitcnt vmcnt(0)" ::: "memory");
    } else {
      XB_SPIN(xb_ld(&bar[XB_XGEN(b.x)]) == gen, bar);
      __builtin_amdgcn_fence(__ATOMIC_ACQUIRE, "agent");
      asm volatile("s_waitcnt vmcnt(0)" ::: "memory");
    }
  }
  __syncthreads();
}

namespace pg8 {
#define PG8_LAS __attribute__((address_space(3)))
constexpr int BM = 256, BK = 64, HALF = 128, HTB = HALF * BK * 2  , STAGE_BYTES = 8 * HTB, NXCD = 8, WGM = 8;
__host__ __device__ __forceinline__ int lds_byte(int r, int c) { const int st = (r >> 4) * 2 + (c >> 5), rr = r & 15, cc = c & 31, ob = rr * 64 + cc * 2; return st * 1024 + (ob ^ (((ob >> 9) & 1) << 5)); }
__host__ __device__ __forceinline__ void stage_rc(int b, int& R, int& C) { const int st = b / 1024, sb = b % 1024, swz = sb ^ (((sb >> 9) & 1) << 5); R = (st >> 1) * 16 + swz / 64; C = (st & 1) * 32 + (swz % 64) / 2; }
__host__ __device__ __forceinline__ int perm32(int rho) { const int n = rho >> 4, i = rho & 15; return 8 * (i >> 2) + 4 * n + (i & 3); }

struct Unit { int pm, pn, pa, ks; };
struct Gemm { const bf16_t* A; const bf16_t* Bt; int M, N, K, kLen; };

struct StaticOrder {
    int nM, nN, nwg, G, c, map, a_local, c_local, nNr;
    __device__ void init(int nMt, int nNt, int G_, int c_, int map_, int a_local_, int c_local_, int nsplit = 1) { nM = nMt; nNr = nNt; nN = nNt * nsplit; nwg = nM * nN; G = G_; c = c_; map = map_; a_local = a_local_; c_local = c_local_; }
    __device__ bool next(int i, Unit& u) const {
        const long L = (long)i * G + c; if (L >= nwg) return false;
        int wgid = (int)L; { const int q = nwg / NXCD, r = nwg % NXCD, xcd = wgid % NXCD, off = wgid / NXCD; wgid = (xcd < r ? xcd * (q + 1) : r * (q + 1) + (xcd - r) * q) + off; }
        const int nig = WGM * nN, gid = wgid / nig, fm = gid * WGM, gsz = (nM - fm) < WGM ? (nM - fm) : WGM;
        const int mi = fm + ((wgid % nig) % gsz); const int pne = (wgid % nig) / gsz; u.ks = pne / nNr; u.pn = pne - u.ks * nNr;
        const int gt = map == 0 ? mi : (map == 1 ? ((mi >> 3) * 9 + 1 + (mi & 7)) : mi * 9);
        u.pa = a_local ? mi : gt; u.pm = c_local ? mi : gt; return true;
    }
    __device__ __forceinline__ void a_ready(const Unit&) const {}
    __device__ __forceinline__ void done(const Unit&) const {}
};

template <int ACT  > struct EpiBf16 {
    static constexpr bool PERM = true, AFTER_DRAIN = false;
    bf16_t* O; int ldc; size_t slab;
    __device__ __forceinline__ void operator()(const f32x4 (&acc)[2][2][4][2], const Unit& u, int wr, int wc, int fr, int fq) const {
        const int row0 = u.pm * BM + wr * 64 + fr; const int col0 = u.pn * BM + wc * 32 + 8 * fq;
        bf16_t* Ob = O + (size_t)u.ks * slab;
#pragma unroll
        for (int ai = 0; ai < 2; ++ai)
#pragma unroll
            for (int m = 0; m < 4; ++m) { bf16_t* rowp = Ob + (size_t)(row0 + ai * HALF + m * 16) * ldc + col0;
#pragma unroll
                for (int bj = 0; bj < 2; ++bj) { f32x4 v0 = acc[ai][bj][m][0], v1 = acc[ai][bj][m][1];
                    if (ACT == 2) {
#pragma unroll
                        for (int j = 0; j < 4; ++j) { const float a = v0[j] > 0.f ? v0[j] : 0.f, b = v1[j] > 0.f ? v1[j] : 0.f; v0[j] = a * a; v1[j] = b * b; } }
                    u32x4 w; w.x = pk2(v0[0], v0[1]); w.y = pk2(v0[2], v0[3]); w.z = pk2(v1[0], v1[1]); w.w = pk2(v1[2], v1[3]);
                    *(u32x4*)(rowp + bj * HALF) = w; } }
    }
};
struct EpiInproj {
    static constexpr bool PERM = false, AFTER_DRAIN = false;
    const float* qk_g; const float* rt; bf16_t* Qb; bf16_t* Kb; bf16_t* Vt; int layer;
    __device__ __forceinline__ void operator()(const f32x4 (&acc)[2][2][4][2], const Unit& u, int wr, int wc, int fr, int fq) const {
        asm volatile("" : "+v"(fr), "+v"(fq));
        const int hc = 4 * u.pn + wc;
        const bool even = (layer == 0);
        int kind, cidx;
        if (hc < 8) { kind = 0; cidx = hc; } else if (hc < 10) { kind = 1; cidx = hc - 8; } else if (hc < 12) { kind = 2; cidx = hc - 10; }
        else if (hc < 20) { kind = 0; cidx = hc - 12 + 8; } else if (hc < 28) { kind = 1; cidx = hc - 20 + 2; } else { kind = 2; cidx = hc - 28 + 2; }
        const bool do_norm = even && hc < 10;
        const bool do_rope = (hc < 10) || (even && hc >= 12 && hc < 28);
        const float qscale = (kind == 0) ? 0.125f * LOG2E : 1.f;
        const float* g = qk_g + (hc < 8 ? 0 : 64);
        const int grow0 = u.pm * BM;
        const int b = grow0 / P, p0 = grow0 - b * P;
        const bool latent = p0 >= LC;
#pragma unroll
        for (int ai = 0; ai < 2; ++ai)
#pragma unroll
        for (int m = 0; m < 4; ++m) {
            const int rl = ai * HALF + wr * 64 + m * 16 + fr, pp = p0 + rl;
            f32x4 v[4];
#pragma unroll
            for (int nt = 0; nt < 4; ++nt) v[nt] = acc[ai][nt >> 1][m][nt & 1];
            if (do_norm) {
                float ss = 0.f;
#pragma unroll
                for (int nt = 0; nt < 4; ++nt) ss += v[nt][0] * v[nt][0] + v[nt][1] * v[nt][1] + v[nt][2] * v[nt][2] + v[nt][3] * v[nt][3];
                ss += __shfl_xor(ss, 16); ss += __shfl_xor(ss, 32);
                const float rstd = rsqrtf(ss * (1.f / 64.f) + EPS);
#pragma unroll
                for (int nt = 0; nt < 4; ++nt) { const f32x4 gv = *(const f32x4*)(g + nt * 16 + fq * 4); v[nt] = v[nt] * rstd * gv; }
            }
            if (do_rope && latent) {
                const int tt = pp - LC, pr = tt >> 6, pc = tt & 63;
                const f32x4 c0 = *(const f32x4*)(rt + pr * 16 + fq * 4), s0 = *(const f32x4*)(rt + 1024 + pr * 16 + fq * 4);
                const f32x4 c1 = *(const f32x4*)(rt + pc * 16 + fq * 4), s1 = *(const f32x4*)(rt + 1024 + pc * 16 + fq * 4);
                const f32x4 a1 = v[0], a2 = v[1], b1 = v[2], b2 = v[3];
                v[0] = a1 * c0 - a2 * s0; v[1] = a2 * c0 + a1 * s0;
                v[2] = b1 * c1 - b2 * s1; v[3] = b2 * c1 + b1 * s1;
            }
            if (kind == 0) {
                bf16_t* d = Qb + (size_t)(grow0 + rl) * 1024 + cidx * 64 + fq * 4;
#pragma unroll
                for (int nt = 0; nt < 4; ++nt) { const f32x4 o = v[nt] * qscale; *(u32x2*)(d + nt * 16) = (u32x2){pk2(o[0], o[1]), pk2(o[2], o[3])}; }
            } else if (kind == 1) {
                bf16_t* d = Kb + (size_t)(grow0 + rl) * 640 + cidx * 64 + fq * 4;
#pragma unroll
                for (int nt = 0; nt < 4; ++nt) *(u32x2*)(d + nt * 16) = (u32x2){pk2(v[nt][0], v[nt][1]), pk2(v[nt][2], v[nt][3])};
            } else {
                bf16_t* d = Vt + ((size_t)(b * 10 + cidx) * 64 + fq * 4) * P + pp;
#pragma unroll
                for (int nt = 0; nt < 4; ++nt) {
                    const unsigned u0 = pk2(v[nt][0], v[nt][1]), u1 = pk2(v[nt][2], v[nt][3]);
                    bf16_t* dd = d + (size_t)(nt * 16) * P;
                    dd[0] = (bf16_t)(u0 & 0xffffu); dd[P] = (bf16_t)(u0 >> 16); dd[2 * P] = (bf16_t)(u1 & 0xffffu); dd[3 * P] = (bf16_t)(u1 >> 16);
                }
            }
            asm volatile("" ::: "memory");
        }
    }
};
template <class Epi, class Sched, bool ALIGN_EPI = false, bool SP2 = false>
__device__ __forceinline__ void gemm_phase(PG8_LAS unsigned char* lds, const Gemm g, const Sched& S, const Epi& E, const int tid) {
    const int wid = __builtin_amdgcn_readfirstlane(tid >> 6), lane = tid & 63, wr = wid >> 2, wc = wid & 3, fr = lane & 15, fq = lane >> 4;
    const int K = g.K, nt = g.kLen / BK;
    unsigned voffA[2], voffB[2];
#pragma unroll
    for (int i = 0; i < 2; ++i) { int R, C; stage_rc(tid * 16 + i * 8192, R, C); const int Rb = Epi::PERM ? ((R & ~31) + perm32(R & 31)) : R;
        voffA[i] = (unsigned)(R * K + C) * 2u; voffB[i] = (unsigned)(Rb * K + C) * 2u; }
    const size_t kstep = (size_t)(BK * 2);
    const size_t hstep = (size_t)HALF * K * 2;
    const size_t tstep = 2 * hstep;
    const unsigned ldsw = (unsigned)wid * 1024u;
    const int aoff = lds_byte(wr * 64 + fr, fq * 8), boff = lds_byte(wc * 32 + fr, fq * 8);
#define PG8_SA(b, h) (((b) * 2 + (h)) * HTB)
#define PG8_SB(b, h) ((4 + (b) * 2 + (h)) * HTB)
#define PG8_STAGE(bufoff, gbase, voff) do { _Pragma("unroll") for (int _i = 0; _i < 2; ++_i) \
        __builtin_amdgcn_global_load_lds((const unsigned*)((const char*)(gbase) + (voff)[_i]), (PG8_LAS unsigned*)(lds + (bufoff) + ldsw + _i * 8192), 16, 0, 0); } while (0)
#define PG8_LDA(dst, b, h) do { _Pragma("unroll") for (int m = 0; m < 4; ++m) _Pragma("unroll") for (int k = 0; k < 2; ++k) dst[m][k] = *(const PG8_LAS bf16x8*)(lds + PG8_SA(b, h) + aoff + m * 2048 + k * 1024); } while (0)
#define PG8_LDB(dst, b, h) do { _Pragma("unroll") for (int n = 0; n < 2; ++n) _Pragma("unroll") for (int k = 0; k < 2; ++k) dst[n][k] = *(const PG8_LAS bf16x8*)(lds + PG8_SB(b, h) + boff + n * 2048 + k * 1024); } while (0)
#define PG8_MMA(ai, bj, At, Bt) do { __builtin_amdgcn_s_setprio(1); _Pragma("unroll") for (int m = 0; m < 4; ++m) _Pragma("unroll") for (int n = 0; n < 2; ++n) _Pragma("unroll") for (int k = 0; k < 2; ++k) \
        acc[ai][bj][m][n] = __builtin_amdgcn_mfma_f32_16x16x32_bf16(Bt[n][k], At[m][k], acc[ai][bj][m][n], 0, 0, 0); __builtin_amdgcn_s_setprio(0); } while (0)
#define PG8_WAIT_V(n) asm volatile("s_waitcnt vmcnt(" #n ")" ::: "memory")
#define PG8_WAIT_L(n) asm volatile("s_waitcnt lgkmcnt(" #n ")" ::: "memory")
#define PG8_BAR __builtin_amdgcn_s_barrier()
#define PG8_SCHED __builtin_amdgcn_sched_barrier(0)
    Unit cur, nxt; int ui = 0;
    if (!S.next(0, cur)) return;
    f32x4 acc[2][2][4][2];
#pragma unroll
    for (int a = 0; a < 2; ++a)
#pragma unroll
        for (int b = 0; b < 2; ++b)
#pragma unroll
            for (int m = 0; m < 4; ++m)
#pragma unroll
                for (int n = 0; n < 2; ++n) acc[a][b][m][n] = (f32x4){0.f, 0.f, 0.f, 0.f};
    bf16x8 At[4][2], B0[2][2], B1[2][2];
    const char* cA = (const char*)g.A + (size_t)cur.pa * tstep + (size_t)cur.ks * g.kLen * 2; const char* cB = (const char*)g.Bt + (size_t)cur.pn * tstep + (size_t)cur.ks * g.kLen * 2;
    S.a_ready(cur);
    if constexpr (SP2) {
        PG8_STAGE(PG8_SB(0, 0), cB, voffB); PG8_STAGE(PG8_SB(0, 1), cB + hstep, voffB); PG8_STAGE(PG8_SA(0, 0), cA, voffA); PG8_STAGE(PG8_SA(0, 1), cA + hstep, voffA);
        if (wr == 1) PG8_BAR;
        PG8_WAIT_V(2); PG8_BAR;
        PG8_STAGE(PG8_SB(1, 0), cB + kstep, voffB); PG8_STAGE(PG8_SA(1, 0), cA + kstep, voffA); PG8_STAGE(PG8_SB(1, 1), cB + hstep + kstep, voffB);
        PG8_WAIT_V(6); PG8_BAR;
    } else {
        PG8_STAGE(PG8_SB(0, 0), cB, voffB); PG8_STAGE(PG8_SA(0, 0), cA, voffA); PG8_STAGE(PG8_SB(0, 1), cB + hstep, voffB); PG8_STAGE(PG8_SA(0, 1), cA + hstep, voffA);
        if (wr == 1) PG8_BAR;
        PG8_WAIT_V(4); PG8_BAR;
        PG8_STAGE(PG8_SB(1, 0), cB + kstep, voffB); PG8_STAGE(PG8_SA(1, 0), cA + kstep, voffA); PG8_STAGE(PG8_SB(1, 1), cB + hstep + kstep, voffB);
        PG8_WAIT_V(6); PG8_BAR;
    }
    for (;;) {
        const bool has_next = S.next(ui + 1, nxt);
        const char* nA = has_next ? (const char*)g.A + (size_t)nxt.pa * tstep + (size_t)nxt.ks * g.kLen * 2 : cA; const char* nB = has_next ? (const char*)g.Bt + (size_t)nxt.pn * tstep + (size_t)nxt.ks * g.kLen * 2 : cB;
        for (int t = 0; t < nt; t += 2) {
            const bool last = (t == nt - 2);
            const char* a1 = cA + (size_t)(t + 1) * kstep;
            const char* a2 = last ? nA : cA + (size_t)(t + 2) * kstep; const char* b2 = last ? nB : cB + (size_t)(t + 2) * kstep;
            const char* a3 = a2 + kstep; const char* b3 = b2 + kstep;
            if (last && has_next) S.a_ready(nxt);
            if constexpr (SP2) {
            PG8_LDB(B0, 0, 0); PG8_LDB(B1, 0, 1); PG8_SCHED; PG8_LDA(At, 0, 0); PG8_STAGE(PG8_SA(1, 1), a1 + hstep, voffA);
            PG8_WAIT_V(8); PG8_WAIT_L(0); PG8_BAR; PG8_MMA(0, 0, At, B0); PG8_MMA(0, 1, At, B1); PG8_BAR; PG8_SCHED;
            PG8_LDA(At, 0, 1); PG8_STAGE(PG8_SB(0, 0), b2, voffB); PG8_STAGE(PG8_SB(0, 1), b2 + hstep, voffB); PG8_STAGE(PG8_SA(0, 0), a2, voffA);
            PG8_WAIT_V(8); PG8_WAIT_L(0); PG8_BAR; PG8_MMA(1, 0, At, B0); PG8_MMA(1, 1, At, B1); PG8_BAR; PG8_SCHED;
            PG8_LDB(B0, 1, 0); PG8_LDB(B1, 1, 1); PG8_SCHED; PG8_LDA(At, 1, 0); PG8_STAGE(PG8_SA(0, 1), a2 + hstep, voffA);
            PG8_WAIT_V(8); PG8_WAIT_L(0); PG8_BAR; PG8_MMA(0, 0, At, B0); PG8_MMA(0, 1, At, B1); PG8_BAR; PG8_SCHED;
            PG8_LDA(At, 1, 1); PG8_STAGE(PG8_SB(1, 0), b3, voffB); PG8_STAGE(PG8_SB(1, 1), b3 + hstep, voffB); PG8_STAGE(PG8_SA(1, 0), a3, voffA);
            PG8_WAIT_V(8); PG8_WAIT_L(0); PG8_BAR; PG8_MMA(1, 0, At, B0); PG8_MMA(1, 1, At, B1); PG8_BAR; PG8_SCHED;
            } else {
            PG8_LDB(B0, 0, 0); PG8_SCHED; PG8_LDA(At, 0, 0); PG8_STAGE(PG8_SA(1, 1), a1 + hstep, voffA);
            PG8_WAIT_L(8); PG8_BAR; PG8_WAIT_L(0); PG8_MMA(0, 0, At, B0); PG8_BAR; PG8_SCHED;
            PG8_LDB(B1, 0, 1); PG8_STAGE(PG8_SB(0, 0), b2, voffB);
            PG8_BAR; PG8_WAIT_L(0); PG8_MMA(0, 1, At, B1); PG8_BAR;
            PG8_LDA(At, 0, 1); PG8_STAGE(PG8_SA(0, 0), a2, voffA);
            PG8_BAR; PG8_WAIT_L(0); PG8_MMA(1, 0, At, B0); PG8_BAR; PG8_SCHED;
            PG8_STAGE(PG8_SB(0, 1), b2 + hstep, voffB);
            PG8_WAIT_V(6); PG8_BAR; PG8_MMA(1, 1, At, B1); PG8_BAR;
            PG8_LDB(B0, 1, 0); PG8_SCHED; PG8_LDA(At, 1, 0); PG8_STAGE(PG8_SA(0, 1), a2 + hstep, voffA);
            PG8_WAIT_L(8); PG8_BAR; PG8_WAIT_L(0); PG8_MMA(0, 0, At, B0); PG8_BAR; PG8_SCHED;
            PG8_LDB(B1, 1, 1); PG8_STAGE(PG8_SB(1, 0), b3, voffB);
            PG8_BAR; PG8_WAIT_L(0); PG8_MMA(0, 1, At, B1); PG8_BAR;
            PG8_LDA(At, 1, 1); PG8_STAGE(PG8_SA(1, 0), a3, voffA);
            PG8_BAR; PG8_WAIT_L(0); PG8_MMA(1, 0, At, B0); PG8_BAR; PG8_SCHED;
            PG8_STAGE(PG8_SB(1, 1), b3 + hstep, voffB);
            PG8_WAIT_V(6); PG8_BAR; PG8_MMA(1, 1, At, B1); PG8_BAR;
            }
        }
        if constexpr (ALIGN_EPI) { if (wr == 0) PG8_BAR; }
        if constexpr (!Epi::AFTER_DRAIN) { E(acc, cur, wr, wc, fr, fq); S.done(cur); }
        if (!has_next) break;
#pragma unroll
        for (int a = 0; a < 2; ++a)
#pragma unroll
            for (int b = 0; b < 2; ++b)
#pragma unroll
                for (int m = 0; m < 4; ++m)
#pragma unroll
                    for (int n = 0; n < 2; ++n) acc[a][b][m][n] = (f32x4){0.f, 0.f, 0.f, 0.f};
        cur = nxt; cA = nA; cB = nB; ++ui;
        if constexpr (ALIGN_EPI) { if (wr == 1) PG8_BAR; }
    }
    PG8_WAIT_V(0);
    if constexpr (!ALIGN_EPI) { if (wr == 0) PG8_BAR; }
    PG8_BAR;
    if constexpr (Epi::AFTER_DRAIN) { E.fused(acc, cur, wr, wc, fr, fq, lds, wid, lane); S.done(cur); }
#undef PG8_SA
#undef PG8_SB
#undef PG8_STAGE
#undef PG8_LDA
#undef PG8_LDB
#undef PG8_MMA
#undef PG8_WAIT_V
#undef PG8_WAIT_L
#undef PG8_BAR
#undef PG8_SCHED
}}

DI void p0_transpose(const Ctx& cx, const float* W, bf16_t* Wt, int K, int N, int tk, int tn, int perm, unsigned char* lds) {
  float* s = (float*)lds;
  const int t = cx.tid;
  __syncthreads();
#pragma unroll
  for (int i = 0; i < 8; ++i) { const int k = i * 8 + (t >> 6), n = t & 63; s[k * 65 + n] = W[(size_t)(tk * 64 + k) * N + tn * 64 + n]; }
  __syncthreads();
#pragma unroll
  for (int i = 0; i < 4; ++i) { const int n = i * 16 + (t >> 5), kk = (t & 31) * 2;
    const int orow = perm ? (256 * (tn >> 2) + 128 * (n >> 5) + 32 * (tn & 3) + (n & 31)) : tn * 64 + n;
    *(unsigned*)(Wt + (size_t)orow * K + tk * 64 + kk) = pk2(s[kk * 65 + n], s[(kk + 1) * 65 + n]); }
}
DI void p0_mod(const Ctx& cx, const Params& p, int item, unsigned char* lds) {
  float* sS = (float*)lds;
  float* red = (float*)(lds + 9 * 1024 * 4);
  const int t = cx.tid, lane = t & 63, w = t >> 6;
  const int l = item / 96, cc = item % 96;
  __syncthreads();
  for (int e = t; e < 9 * 1024; e += NTHR) { const int i = e >> 10, k = e & 1023; const float v = (i < 8) ? p.c[i * 1024 + k] : p.c_ctx[k]; sS[e] = v / (1.f + __expf(-v)); }
  __syncthreads();
  float acc[9];
#pragma unroll
  for (int i = 0; i < 9; ++i) acc[i] = 0.f;
  const float* wp = p.w_mod + (size_t)l * 1024 * 6144 + cc * 64 + lane;
  for (int k = w * 128; k < w * 128 + 128; ++k) { const float wv = wp[(size_t)k * 6144];
#pragma unroll
    for (int i = 0; i < 9; ++i) acc[i] += sS[i * 1024 + k] * wv; }
#pragma unroll
  for (int i = 0; i < 9; ++i) red[(w * 9 + i) * 64 + lane] = acc[i];
  __syncthreads();
  float* mod = (float*)(p.ws + OFF_MOD);
  for (int e = t; e < 576; e += NTHR) { const int i = e >> 6, n = e & 63;
    float v = p.b_mod[l * 6144 + cc * 64 + n];
#pragma unroll
    for (int ww = 0; ww < 8; ++ww) v += red[(ww * 9 + i) * 64 + n];
    mod[(size_t)(l * 9 + i) * 6144 + cc * 64 + n] = v; }
}
DI void phase_prep(const Ctx& cx, const Params& p, unsigned char* lds, int l, int misc) {
  const int N_MISC = misc ? 193 : 0;
  constexpr int TW_IN = 16 * 36, TW_OUT = 16 * 16, TW_1 = 16 * 64, TW_2 = 64 * 16, TW_L = TW_IN + TW_OUT + TW_1 + TW_2;
  const int total = N_MISC + TW_L;
  for (int it = cx.bid; it < total; it += cx.nb) {
    if (it < N_MISC) {
      if (it < 192) p0_mod(cx, p, it, lds);
      else { float* rt = (float*)(p.ws + OFF_ROPE);
        for (int e = cx.tid; e < 1024; e += NTHR) { const int pos = e >> 4, f = e & 15; const float inv = powf(10000.f, -(float)f / 16.f); const float ang = (float)pos * inv;
          rt[e] = cosf(ang); rt[1024 + e] = sinf(ang); } }
    } else {
      int i = it - N_MISC;
      if (i < TW_IN) { p0_transpose(cx, p.w_in + (size_t)l * DM * INW, (bf16_t*)(p.ws + OFF_WIN), DM, INW, i / 36, i % 36, 1, lds); }
      else if (i < TW_IN + TW_OUT) { i -= TW_IN; p0_transpose(cx, p.w_out + (size_t)l * DM * DM, (bf16_t*)(p.ws + OFF_WOUT), DM, DM, i / 16, i % 16, 0, lds); }
      else if (i < TW_IN + TW_OUT + TW_1) { i -= TW_IN + TW_OUT; p0_transpose(cx, p.w_mlp_in + (size_t)l * DM * FF, (bf16_t*)(p.ws + OFF_W1), DM, FF, i / 64, i % 64, 0, lds); }
      else { i -= TW_IN + TW_OUT + TW_1; p0_transpose(cx, p.w_mlp_out + (size_t)l * FF * DM, (bf16_t*)(p.ws + OFF_W2), FF, DM, i / 16, i % 16, 0, lds); }
    }
  }
}

DI float wave_sum(float v) {
#pragma unroll
  for (int o = 32; o >= 1; o >>= 1) v += __shfl_xor(v, o);
  return v;
}
DI void phase_rowpass(const Ctx& cx, const Params& p, int mode, int layer) {
  constexpr int NR = 2;
  const int lane = cx.tid & 63, w = cx.tid >> 6;
  const bool latent_only = (layer == 1 && mode != 0);
  const int nrows = latent_only ? NB * T : R;
  bf16_t* X = (bf16_t*)(p.ws + OFF_X);
  bf16_t* HA = (bf16_t*)(p.ws + OFF_A);
  const bf16_t* MF = (const bf16_t*)(p.ws + OFF_B);
  const float* mod = (const float*)(p.ws + OFF_MOD);
  const bool from_in = (mode == 0 || (mode == 1 && layer == 0));
  const bool to_out = (mode == 2 && layer == 1);
  for (int it0 = (cx.bid * NWV + w) * NR; it0 < nrows; it0 += cx.nb * NWV * NR) {
    int row[NR], bb[NR], pp[NR], mi[NR]; bool ok[NR];
    f32x4 xv[NR][4], mv[NR][4];
#pragma unroll
    for (int r = 0; r < NR; ++r) {
      const int it = it0 + r; ok[r] = it < nrows; const int itc = ok[r] ? it : it0;
      row[r] = latent_only ? ((itc >> 11) * P + LC + (itc & 2047)) : itc;
      bb[r] = row[r] / P; pp[r] = row[r] - bb[r] * P; mi[r] = (pp[r] < LC) ? 8 : bb[r];
    }
#pragma unroll
    for (int r = 0; r < NR; ++r) {
      if (from_in) {
        const float* resid = (pp[r] < LC) ? p.ctx + ((size_t)bb[r] * LC + pp[r]) * DM : p.x + ((size_t)bb[r] * T + pp[r] - LC) * DM;
#pragma unroll
        for (int i = 0; i < 4; ++i) xv[r][i] = *(const f32x4*)(resid + lane * 4 + 256 * i);
      } else {
        const bf16_t* resid = X + (size_t)row[r] * DM;
#pragma unroll
        for (int i = 0; i < 4; ++i) { const u32x2 u = *(const u32x2*)(resid + lane * 4 + 256 * i); xv[r][i] = (f32x4){bflo(u.x), bfhi(u.x), bflo(u.y), bfhi(u.y)}; }
      }
      if (mode != 0) {
        if (mode == 2 && layer == 0 && pp[r] < LC) {
          const bf16_t* sl = (const bf16_t*)(p.ws + OFF_SLAB) + (size_t)(bb[r] * LC + pp[r]) * DM;
#pragma unroll
          for (int i = 0; i < 4; ++i) mv[r][i] = (f32x4){0.f, 0.f, 0.f, 0.f};
#pragma unroll
          for (int k8 = 0; k8 < 8; ++k8) {
#pragma unroll
            for (int i = 0; i < 4; ++i) { const u32x2 u = *(const u32x2*)(sl + (size_t)k8 * NB * LC * DM + lane * 4 + 256 * i); mv[r][i] = mv[r][i] + (f32x4){bflo(u.x), bfhi(u.x), bflo(u.y), bfhi(u.y)}; }
          }
        } else {
          const bf16_t* src = (mode == 1 ? MF : HA) + (size_t)row[r] * DM;
#pragma unroll
          for (int i = 0; i < 4; ++i) { const u32x2 u = *(const u32x2*)(src + lane * 4 + 256 * i); mv[r][i] = (f32x4){bflo(u.x), bfhi(u.x), bflo(u.y), bfhi(u.y)}; }
        }
      }
    }
    if (mode != 0) {
      float ss[NR];
#pragma unroll
      for (int r = 0; r < NR; ++r) { ss[r] = 0.f;
#pragma unroll
        for (int i = 0; i < 4; ++i) ss[r] += mv[r][i][0] * mv[r][i][0] + mv[r][i][1] * mv[r][i][1] + mv[r][i][2] * mv[r][i][2] + mv[r][i][3] * mv[r][i][3]; }
#pragma unroll
      for (int o = 32; o >= 1; o >>= 1) {
#pragma unroll
        for (int r = 0; r < NR; ++r) ss[r] += __shfl_xor(ss[r], o); }
      const float* na = p.norm_g + (size_t)(layer * 4 + (mode == 1 ? 1 : 3)) * DM;
#pragma unroll
      for (int r = 0; r < NR; ++r) {
        const float rstd = rsqrtf(ss[r] * (1.f / DM) + EPS);
        const float* gate = mod + (size_t)(layer * 9 + mi[r]) * 6144 + (mode == 1 ? 2048 : 5120);
#pragma unroll
        for (int i = 0; i < 4; ++i) { const f32x4 g = *(const f32x4*)(gate + lane * 4 + 256 * i), n = *(const f32x4*)(na + lane * 4 + 256 * i);
          xv[r][i] = xv[r][i] + g * (mv[r][i] * rstd * n); }
        if (ok[r]) {
          if (to_out) {
            float* dst = p.out + ((size_t)bb[r] * T + pp[r] - LC) * DM;
#pragma unroll
            for (int i = 0; i < 4; ++i) *(f32x4*)(dst + lane * 4 + 256 * i) = xv[r][i];
          } else {
            bf16_t* dst = X + (size_t)row[r] * DM;
#pragma unroll
            for (int i = 0; i < 4; ++i) *(u32x2*)(dst + lane * 4 + 256 * i) = (u32x2){pk2(xv[r][i][0], xv[r][i][1]), pk2(xv[r][i][2], xv[r][i][3])};
          }
        }
      }
    }
    if (!to_out) {
      float ss[NR];
#pragma unroll
      for (int r = 0; r < NR; ++r) { ss[r] = 0.f;
#pragma unroll
        for (int i = 0; i < 4; ++i) ss[r] += xv[r][i][0] * xv[r][i][0] + xv[r][i][1] * xv[r][i][1] + xv[r][i][2] * xv[r][i][2] + xv[r][i][3] * xv[r][i][3]; }
#pragma unroll
      for (int o = 32; o >= 1; o >>= 1) {
#pragma unroll
        for (int r = 0; r < NR; ++r) ss[r] += __shfl_xor(ss[r], o); }
#pragma unroll
      for (int r = 0; r < NR; ++r) {
        const float* modp = mod + (size_t)(layer * 9 + mi[r]) * 6144;
        const float* nb; const float* sh; const float* sc;
        if (mode == 0) { nb = p.norm_g + (size_t)(layer * 4 + 0) * DM; sh = modp; sc = modp + 1024; }
        else if (mode == 1) { nb = p.norm_g + (size_t)(layer * 4 + 2) * DM; sh = modp + 3072; sc = modp + 4096; }
        else { const float* modn = mod + (size_t)((layer + 1) * 9 + mi[r]) * 6144; nb = p.norm_g + (size_t)((layer + 1) * 4 + 0) * DM; sh = modn; sc = modn + 1024; }
        const float rstd = rsqrtf(ss[r] * (1.f / DM) + EPS);
        bf16_t* hd = HA + (size_t)row[r] * DM;
        if (ok[r]) {
#pragma unroll
          for (int i = 0; i < 4; ++i) { const f32x4 n = *(const f32x4*)(nb + lane * 4 + 256 * i), s1 = *(const f32x4*)(sc + lane * 4 + 256 * i), s0 = *(const f32x4*)(sh + lane * 4 + 256 * i);
            const f32x4 hv = (xv[r][i] * rstd * n) * (1.f + s1) + s0;
            *(u32x2*)(hd + lane * 4 + 256 * i) = (u32x2){pk2(hv[0], hv[1]), pk2(hv[2], hv[3])}; }
        }
      }
    }
  }
}

constexpr int VS_OFF = 16384, ABUF = 36864  , RPB_OFF = 2 * ABUF;
template <int MODE>
DI void attn_item(const Ctx& cx, const Params& p, unsigned char* lds, int b, int h, int q0, int n0, int t1s, int t1e) {
  constexpr int NDB = (MODE == 1) ? 4 : 2;
  constexpr int NK = (MODE == 1) ? 2 : 1;
  constexpr int NVC = NDB / 2;
  const int t = cx.tid, lane = t & 63, w = t >> 6, r32 = lane & 31, hh = lane >> 5;
  const bf16_t* Qb = (const bf16_t*)(p.ws + OFF_Q); const bf16_t* Kb = (const bf16_t*)(p.ws + OFF_K); const bf16_t* Vt = (const bf16_t*)(p.ws + OFF_VT);
  bf16_t* Ob = (bf16_t*)(p.ws + OFF_A);
  int cq, ck, cv, kidx, qoff, ocol;
  if (MODE == 0 || MODE == 2) { cq = h; ck = h >> 2; cv = h >> 2; kidx = 0; qoff = 32 * w; ocol = h * 64; }
  else if (MODE == 3) { cq = 8 + h; ck = 2 + h; cv = 2 + h; kidx = 0; qoff = 32 * w; ocol = 512 + h * 64; }
  else { const int j = w >> 2; cq = 8 + 2 * h + j; ck = 2 + 2 * h; cv = 2 + 2 * h; kidx = j; qoff = 32 * (w & 3); ocol = 512 + h * 128; }
  const size_t rowbase = (size_t)b * P;
  const int qp = q0 + qoff + r32;
  bf16x8 qf[4];
  { const bf16_t* qptr = Qb + (rowbase + qp) * 1024 + cq * 64 + hh * 8;
#pragma unroll
    for (int ks = 0; ks < 4; ++ks) qf[ks] = *(const bf16x8*)(qptr + ks * 16); }
  float m_run = -1e30f, l_run = 0.f;
  if (MODE == 2) { m_run = p.sink_c[h] * LOG2E; l_run = hh ? 0.f : 1.f; }
  f32x16 O[NDB];
#pragma unroll
  for (int db = 0; db < NDB; ++db)
#pragma unroll
    for (int i = 0; i < 16; ++i) O[db][i] = 0.f;
  __syncthreads();
  const float* rpbs = (const float*)(lds + RPB_OFF);
  if (MODE == 3) { float* rp = (float*)(lds + RPB_OFF); for (int i = t; i < 465; i += NTHR) rp[i] = p.rpb_d[h * 465 + i] * LOG2E; }
  const int srow = t >> 3, skc = t & 7;
  const unsigned ksw = (unsigned)(srow * 128 + ((skc ^ ((srow >> 1) & 7)) << 4));
  const int ksx = (r32 >> 1) & 7;
  u32x4 kreg[NK], vreg[NVC];
  const int ntl = n0 + (t1e - t1s);
  auto tile_of = [&](int i) { return i < n0 ? i : t1s + (i - n0); };
  auto prefetch = [&](int tile) {
    const size_t key0 = rowbase + (size_t)tile * 64;
#pragma unroll
    for (int kk = 0; kk < NK; ++kk) kreg[kk] = *(const u32x4*)(Kb + (key0 + srow) * 640 + (ck + kk) * 64 + skc * 8);
#pragma unroll
    for (int i = 0; i < NVC; ++i) vreg[i] = *(const u32x4*)(Vt + ((size_t)(b * 10 + cv) * 64 + srow + 64 * i) * P + tile * 64 + skc * 8);
  };
  auto stage = [&](int buf) {
    unsigned char* lb = lds + buf * ABUF;
#pragma unroll
    for (int kk = 0; kk < NK; ++kk) *(u32x4*)(lb + kk * 8192 + ksw) = kreg[kk];
#pragma unroll
    for (int i = 0; i < NVC; ++i) { unsigned char* d = lb + VS_OFF + (srow + 64 * i) * 136 + skc * 16;
      *(u32x2*)d = (u32x2){vreg[i].x, vreg[i].y}; *(u32x2*)(d + 8) = (u32x2){vreg[i].z, vreg[i].w}; }
  };
  const int qpos = qp - LC;
  const int qw0 = q0 - LC + qoff;
  const int qr = qpos >> 6, qc = qpos & 63;
  auto xmax32 = [&](float v) {
    const u32x2 r = __builtin_amdgcn_permlane32_swap(__float_as_uint(v), __float_as_uint(v), false, false);
    return fmaxf(__uint_as_float(r.x), __uint_as_float(r.y));
  };
  auto qk = [&](const unsigned char* lb, int kt, f32x16& S) {
    bf16x8 kf[4];
#pragma unroll
    for (int ks = 0; ks < 4; ++ks) kf[ks] = *(const bf16x8*)(lb + kidx * 8192 + (kt * 32 + r32) * 128 + (((2 * ks + hh) ^ ksx) << 4));
#pragma unroll
    for (int i = 0; i < 16; ++i) S[i] = 0.f;
#pragma unroll
    for (int ks = 0; ks < 4; ++ks) S = __builtin_amdgcn_mfma_f32_32x32x16_bf16(kf[ks], qf[ks], S, 0, 0, 0);
  };
  auto softmax_step = [&](f32x16& S, int tile, int kt, int krow_, bf16x8 (&pf)[2]) {
    if (MODE == 2 && tile >= 4) {
      const int dbase = (tile - 4) * 64 + 4 * hh - qpos + 128;
#pragma unroll
      for (int i = 0; i < 16; ++i) { const int ci = kt * 32 + (i & 3) + 8 * (i >> 2); if ((unsigned)(dbase + ci) > 256u) S[i] = -1e30f; }
    }
    if (MODE == 3 && tile >= 4) {
      const int vbase = 4 * hh - clampi(qc - 8, 0, 48);
      const float* rp = rpbs + (krow_ - qr + 7) * 31 + 15 + 4 * hh - qc;
      float bv[16];
#pragma unroll
      for (int i = 0; i < 16; ++i) bv[i] = rp[kt * 32 + (i & 3) + 8 * (i >> 2)];
#pragma unroll
      for (int i = 0; i < 16; ++i) { const int ci = kt * 32 + (i & 3) + 8 * (i >> 2); const bool valid = (unsigned)(vbase + ci) < 16u;
        S[i] = valid ? S[i] + bv[i] : -1e30f; }
    }
    float mx = S[0];
#pragma unroll
    for (int i = 1; i < 16; ++i) mx = fmaxf(mx, S[i]);
    mx = xmax32(mx);
    const float m_new = fmaxf(m_run, mx);
    const bool grew = m_new > m_run;
    const float alpha = __builtin_amdgcn_exp2f(m_run - m_new);
    const f32x2 mm = {m_new, m_new};
    f32x2 ps2 = {0.f, 0.f};
#pragma unroll
    for (int i = 0; i < 16; i += 2) { f32x2 v = (f32x2){S[i], S[i + 1]} - mm; v.x = __builtin_amdgcn_exp2f(v.x); v.y = __builtin_amdgcn_exp2f(v.y); ps2 += v; S[i] = v.x; S[i + 1] = v.y; }
    l_run = l_run * alpha + (ps2.x + ps2.y); m_run = m_new;
    if (__builtin_amdgcn_ballot_w64(grew) != 0ull) {
#pragma unroll
      for (int db = 0; db < NDB; ++db)
#pragma unroll
        for (int i = 0; i < 16; ++i) O[db][i] *= alpha;
    }
#pragma unroll
    for (int s = 0; s < 2; ++s) {
      u32x4 u; u.x = pk2(S[8 * s + 0], S[8 * s + 1]); u.y = pk2(S[8 * s + 2], S[8 * s + 3]); u.z = pk2(S[8 * s + 4], S[8 * s + 5]); u.w = pk2(S[8 * s + 6], S[8 * s + 7]);
      pf[s] = __builtin_bit_cast(bf16x8, u);
    }
  };
  auto pv = [&](const unsigned char* lb, int kt, const bf16x8 (&pf)[2]) {
    bf16x8 vf[NDB][2];
#pragma unroll
    for (int db = 0; db < NDB; ++db)
#pragma unroll
      for (int s = 0; s < 2; ++s) {
        const unsigned char* vb = lb + VS_OFF + (db * 32 + r32) * 136 + (kt * 32 + 16 * s + 4 * hh) * 2;
        const s16x4 lo = *(const s16x4*)vb, hi = *(const s16x4*)(vb + 16);
        vf[db][s] = __builtin_shufflevector(lo, hi, 0, 1, 2, 3, 4, 5, 6, 7);
      }
#pragma unroll
    for (int db = 0; db < NDB; ++db)
#pragma unroll
      for (int s = 0; s < 2; ++s) O[db] = __builtin_amdgcn_mfma_f32_32x32x16_bf16(vf[db][s], pf[s], O[db], 0, 0, 0);
    __builtin_amdgcn_sched_group_barrier(0x100, NDB * 2, 0);
    __builtin_amdgcn_sched_group_barrier(0x008, NDB * 2, 0);
  };
  auto compute = [&](int tile, int buf) {
    const unsigned char* lb = lds + buf * ABUF;
    int krow_ = 0;
    if (MODE == 3 && tile >= 4) { krow_ = tile - 4; const int rs = clampi((qw0 >> 6) - 4, 0, 24); if (krow_ < rs || krow_ >= rs + 8) return; }
    if (MODE == 2 && tile >= 4) { const int k0 = (tile - 4) * 64; if (k0 > qw0 + 31 + 128 || k0 + 63 < qw0 - 128) return; }
    f32x16 S0, S1; bf16x8 pf0[2], pf1[2];
    if (MODE == 1) {
      qk(lb, 0, S0); softmax_step(S0, tile, 0, krow_, pf0); pv(lb, 0, pf0);
      __builtin_amdgcn_sched_barrier(0);
      qk(lb, 1, S1); softmax_step(S1, tile, 1, krow_, pf1); pv(lb, 1, pf1);
      return;
    }
    qk(lb, 0, S0);
    qk(lb, 1, S1);
    __builtin_amdgcn_sched_group_barrier(0x100, 8, 0);
    __builtin_amdgcn_sched_group_barrier(0x008, 8, 0);
    __builtin_amdgcn_sched_barrier(0);
    softmax_step(S0, tile, 0, krow_, pf0);
    __builtin_amdgcn_sched_barrier(0);
    pv(lb, 0, pf0);
    __builtin_amdgcn_sched_barrier(0);
    softmax_step(S1, tile, 1, krow_, pf1);
    __builtin_amdgcn_sched_barrier(0);
    pv(lb, 1, pf1);
  };
  prefetch(tile_of(0));
  stage(0);
  if (ntl > 1) prefetch(tile_of(1));
  __syncthreads();
  for (int i = 0; i < ntl; ++i) {
    if (i + 1 < ntl) stage((i + 1) & 1);
    if (i + 2 < ntl) prefetch(tile_of(i + 2));
    __builtin_amdgcn_sched_barrier(0);
    compute(tile_of(i), i & 1);
    __syncthreads();
  }
  { const u32x2 r = __builtin_amdgcn_permlane32_swap(__float_as_uint(l_run), __float_as_uint(l_run), false, false); l_run = __uint_as_float(r.x) + __uint_as_float(r.y); }
  const float inv = 1.f / l_run;
  bf16_t* orow = Ob + (rowbase + qp) * 1024 + ocol;
  if (MODE != 1) {
#pragma unroll
    for (int db = 0; db < NDB; ++db)
#pragma unroll
      for (int g = 0; g < 4; ++g) {
        const int dv = db * 32 + 8 * g + 4 * hh;
        *(u32x2*)(orow + dv) = (u32x2){pk2(O[db][4 * g] * inv, O[db][4 * g + 1] * inv), pk2(O[db][4 * g + 2] * inv, O[db][4 * g + 3] * inv)};
      }
  } else {
    const float* lp = p.diff_lambda;
    float s1 = lp[lane] * lp[64 + lane], s2 = lp[128 + lane] * lp[192 + lane];
    s1 = wave_sum(s1); s2 = wave_sum(s2);
    const float lam = __expf(s1) - __expf(s2) + 0.2f;
    float* xch = (float*)lds;
    __syncthreads();
    if (w >= 4) {
#pragma unroll
      for (int db = 0; db < NDB; ++db)
#pragma unroll
        for (int i = 0; i < 16; ++i) xch[(db * 32 + crow(i, hh)) * 128 + qoff + r32] = O[db][i] * inv;
    }
    __syncthreads();
    if (w < 4) {
      float ss = 0.f;
#pragma unroll
      for (int db = 0; db < NDB; ++db)
#pragma unroll
        for (int i = 0; i < 16; ++i) { const float o = O[db][i] * inv - lam * xch[(db * 32 + crow(i, hh)) * 128 + qoff + r32]; O[db][i] = o; ss += o * o; }
      ss += __shfl_xor(ss, 32);
      const float rstd = rsqrtf(ss * (1.f / 128.f) + EPS) * 0.8f;
#pragma unroll
      for (int db = 0; db < NDB; ++db)
#pragma unroll
        for (int g = 0; g < 4; ++g) {
          const int dv = db * 32 + 8 * g + 4 * hh;
          const f32x4 sg = *(const f32x4*)(p.diff_subln + dv);
          *(u32x2*)(orow + dv) = (u32x2){pk2(O[db][4 * g] * rstd * sg[0], O[db][4 * g + 1] * rstd * sg[1]), pk2(O[db][4 * g + 2] * rstd * sg[2], O[db][4 * g + 3] * rstd * sg[3])};
        }
    }
  }
}
DI void phase_attn(const Ctx& cx, const Params& p, int layer, unsigned char* lds) {
  const int total = (layer == 0) ? 1152 : 1024;
  const int vcu = (cx.nb & 7) == 0 ? (cx.bid & 7) * (cx.nb >> 3) + (cx.bid >> 3) : cx.bid;
  for (int idx = vcu; idx < total; idx += cx.nb) {
    int mode, b, h, q0, n0 = 4, t1s = 0, t1e = 0;
    if (layer == 0) {
      if (idx < 512) { mode = 0; const int qb = idx & 7; h = (idx >> 3) & 7; b = idx >> 6; q0 = LC + qb * 256; n0 = 36; }
      else if (idx < 1024) { const int i = idx - 512; mode = 1; const int qb = i & 15; h = (i >> 4) & 3; b = i >> 6; q0 = LC + qb * 128; n0 = 36; }
      else if (idx < 1088) { const int i = idx - 1024; mode = 0; h = i & 7; b = i >> 3; q0 = 0; }
      else { const int i = idx - 1088; mode = 1; const int qb = i & 1; h = (i >> 1) & 3; b = i >> 3; q0 = qb * 128; }
    } else {
      const int i = idx & 511; const int qb = i & 7; h = (i >> 3) & 7; b = i >> 6; q0 = LC + qb * 256;
      if (idx < 512) { mode = 3; t1s = 4 + clampi(4 * qb - 4, 0, 24); t1e = 4 + clampi(4 * qb - 1, 0, 24) + 8; }
      else { mode = 2; t1s = 4 + (4 * qb - 2 > 0 ? 4 * qb - 2 : 0); t1e = 4 + (4 * qb + 6 < 32 ? 4 * qb + 6 : 32); }
    }
    if (mode == 0) attn_item<0>(cx, p, lds, b, h, q0, n0, t1s, t1e);
    else if (mode == 1) attn_item<1>(cx, p, lds, b, h, q0, n0, t1s, t1e);
    else if (mode == 2) attn_item<2>(cx, p, lds, b, h, q0, n0, t1s, t1e);
    else attn_item<3>(cx, p, lds, b, h, q0, n0, t1s, t1e);
  }
}

constexpr int NPH = 18;
DI void run_phase(const Ctx& cx, const Params& p, int ph, unsigned char* lds) {
  bf16_t* WIN = (bf16_t*)(p.ws + OFF_WIN); bf16_t* WOUT = (bf16_t*)(p.ws + OFF_WOUT); bf16_t* W1 = (bf16_t*)(p.ws + OFF_W1); bf16_t* W2 = (bf16_t*)(p.ws + OFF_W2);
  bf16_t* RA = (bf16_t*)(p.ws + OFF_A); bf16_t* RB = (bf16_t*)(p.ws + OFF_B); bf16_t* U = (bf16_t*)(p.ws + OFF_U);
  PG8_LAS unsigned char* l3 = (PG8_LAS unsigned char*)lds;
  if (ph == 0) { phase_prep(cx, p, lds, 0, 1); return; }
  if (ph == 1) { phase_rowpass(cx, p, 0, 0); return; }
  const int layer = ph >= 11 ? 1 : 0;
  const int lp = ph - (layer ? 11 : 2);
  pg8::StaticOrder S;
  if (lp == 0) {
    pg8::Gemm g{RA, WIN, R, INW, DM, DM}; S.init(72, 9, cx.nb, cx.bid, 0, 0, 0);
    pg8::EpiInproj E{p.qk_norm_a, (const float*)(p.ws + OFF_ROPE), (bf16_t*)(p.ws + OFF_Q), (bf16_t*)(p.ws + OFF_K), (bf16_t*)(p.ws + OFF_VT), layer};
    pg8::gemm_phase<pg8::EpiInproj, pg8::StaticOrder, true, true>(l3, g, S, E, cx.tid); return;
  }
  if (lp == 1) { phase_attn(cx, p, layer, lds); return; }
  if (lp == 2) {
    pg8::Gemm g{RA, WOUT, R, DM, DM, DM}; S.init(layer ? 64 : 72, 4, cx.nb, cx.bid, layer ? 1 : 0, 0, 0);
    pg8::EpiBf16<0> E{RB, DM, 0};
    pg8::gemm_phase<pg8::EpiBf16<0>, pg8::StaticOrder, true, true>(l3, g, S, E, cx.tid); return;
  }
  if (lp == 3) { phase_rowpass(cx, p, 1, layer); return; }
  const int nmlp = layer ? 2 : 4;
  if (lp < 4 + nmlp) {
    const int pass = (lp - 4) >> 1, isdown = (lp - 4) & 1;
    const int nmt = pass ? 8 : 64, map = pass ? 2 : 1;
    if (!isdown) { pg8::Gemm g{RA, W1, R, FF, DM, DM}; S.init(nmt, 16, cx.nb, cx.bid, map, 0, 1); pg8::EpiBf16<2> E{U, FF, 0};
      pg8::gemm_phase<pg8::EpiBf16<2>, pg8::StaticOrder, true, true>(l3, g, S, E, cx.tid); }
    else if (pass == 0) { pg8::Gemm g{U, W2, R, DM, FF, FF}; S.init(nmt, 4, cx.nb, cx.bid, map, 1, 0); pg8::EpiBf16<0> E{RA, DM, 0};
      pg8::gemm_phase<pg8::EpiBf16<0>, pg8::StaticOrder, true, true>(l3, g, S, E, cx.tid); }
    else {
      pg8::Gemm g{U, W2, R, DM, FF, FF / 8}; S.init(nmt, 4, cx.nb, cx.bid, map, 1, 1, 8); pg8::EpiBf16<0> E{(bf16_t*)(p.ws + OFF_SLAB), DM, (size_t)NB * LC * DM};
      pg8::gemm_phase<pg8::EpiBf16<0>, pg8::StaticOrder, true, true>(l3, g, S, E, cx.tid); }
    return;
  }
  phase_rowpass(cx, p, 2, layer);
  if (layer == 0) phase_prep(cx, p, lds, 1, 0);
}

#if !MULTI
__global__ void __launch_bounds__(NTHR, 2) fwd_megakernel(Params p) {
  extern __shared__ __attribute__((aligned(16))) unsigned char smem[];
  cg::grid_group grid = cg::this_grid();
  XcdBarrier xb; xb.bar = (unsigned*)(p.ws + OFF_BAR); xb.x = xb_xcc_id(); xb.nloc = 0u; xb.nx = 0u;
  if (threadIdx.x == 0) (void)xb_add(&xb.bar[XB_XCNT(xb.x)], 1u);
  if (p.ws == nullptr) grid.sync();
  for (int ph = 0; ph < NPH; ++ph) {
    Ctx cx; cx.tid = threadIdx.x; cx.bid = blockIdx.x; cx.nb = gridDim.x;
    asm volatile("" : "+v"(cx.tid)); asm volatile("" : "+s"(cx.bid));
    run_phase(cx, p, ph, smem);
    if (ph + 1 < NPH) xcd_barrier(xb);
  }
}
#else
__global__ void __launch_bounds__(NTHR, 2) phase_kernel(Params p, int ph) {
  extern __shared__ __attribute__((aligned(16))) unsigned char smem[];
  Ctx cx; cx.tid = threadIdx.x; cx.bid = blockIdx.x; cx.nb = gridDim.x;
  run_phase(cx, p, ph, smem);
}
#endif
#if MULTI
#define MAINK phase_kernel
#else
#define MAINK fwd_megakernel
#endif

extern "C" void kernel_launch(void* const* d_in, const int* in_sizes, int n_in, void* d_out, int out_size, void* d_ws, size_t ws_size, hipStream_t stream) {
  Params p{};
  p.x = (const float*)d_in[0]; p.c = (const float*)d_in[1]; p.ctx = (const float*)d_in[2]; p.c_ctx = (const float*)d_in[3];
  p.w_mod = (const float*)d_in[4]; p.b_mod = (const float*)d_in[5]; p.norm_g = (const float*)d_in[6]; p.w_in = (const float*)d_in[7];
  p.w_out = (const float*)d_in[8]; p.w_mlp_in = (const float*)d_in[9]; p.w_mlp_out = (const float*)d_in[10]; p.qk_norm_a = (const float*)d_in[11];
  p.diff_lambda = (const float*)d_in[12]; p.diff_subln = (const float*)d_in[13]; p.sink_c = (const float*)d_in[14]; p.rpb_d = (const float*)d_in[15];
  p.out = (float*)d_out; p.ws = (unsigned char*)d_ws;
  if (ws_size < WS_END) { fprintf(stderr, "workspace too small: %zu < %zu\n", ws_size, (size_t)WS_END); return; }
  static int grid_blocks = 0;
  if (!grid_blocks) {
    int dev = 0, cus = 0, per_cu = 0;
    hipGetDevice(&dev);
    hipDeviceGetAttribute(&cus, hipDeviceAttributeMultiprocessorCount, dev);
    hipFuncSetAttribute((const void*)MAINK, hipFuncAttributeMaxDynamicSharedMemorySize, LDS_BYTES);
    hipOccupancyMaxActiveBlocksPerMultiprocessor(&per_cu, MAINK, NTHR, LDS_BYTES);
    if (per_cu != 1) fprintf(stderr, "note: occupancy query says %d blocks/CU; launching one per CU\n", per_cu);
    (void)hipGetLastError();
    grid_blocks = cus;
  }
#if MULTI
  for (int ph = 0; ph < NPH; ++ph) phase_kernel<<<dim3(grid_blocks), dim3(NTHR), LDS_BYTES, stream>>>(p, ph);
#else
  hipMemsetAsync(d_ws, 0, 16384, stream);
  void* args[] = {&p};
  hipError_t e = hipLaunchCooperativeKernel((void*)fwd_megakernel, dim3(grid_blocks), dim3(NTHR), args, LDS_BYTES, stream);
  if (e != hipSuccess) fprintf(stderr, "cooperative launch failed: %s (grid %d)\n", hipGetErrorString(e), grid_blocks);
#endif
}
```
